# Optimizing an MI355X kernel written in HIP

```python
import jax, jax.numpy as jnp
from jax import lax
import numpy as np

D_MODEL = 1024
BATCH = 2
SEQ = 8192
DEPTH = 1
DEC_BATCH = 32
DEC_SEQ = 1
PAST_LEN = 8192
PAGE_SIZE = 128

HEAD_DIM = 64
HEADS_PER_GROUP = 8
WINDOWS = (128, 512, 2048)
DILATIONS = (1, 4, 16)
N_GROUPS = 3
GROUP_WIDTH = HEADS_PER_GROUP * HEAD_DIM
ATTN_WIDTH = N_GROUPS * GROUP_WIDTH
D_CONV = D_MODEL
CONV_WIDTH = 3
D_FF = 4 * D_MODEL
Q_BLOCK = 128
EPS = 1e-6
NEG = -1e30
IN_WIDTH = 3 * ATTN_WIDTH + 3 * D_CONV + 2 * D_MODEL
SPLIT_POINTS = (ATTN_WIDTH, 2 * ATTN_WIDTH, 3 * ATTN_WIDTH,
                3 * ATTN_WIDTH + D_CONV, 3 * ATTN_WIDTH + 2 * D_CONV,
                3 * ATTN_WIDTH + 3 * D_CONV, 3 * ATTN_WIDTH + 3 * D_CONV + D_MODEL)

kernel_name = "hybrid_dilated_attn_shortconv_decoder_step"


def _rms_norm(x, g):
    xf = x.astype(jnp.float32)
    y = xf * lax.rsqrt(jnp.mean(xf * xf, axis=-1, keepdims=True) + EPS)
    return (y * g.astype(jnp.float32)).astype(x.dtype)


def _project(h, w_in):
    b, t, _ = h.shape
    p = jnp.einsum('btd,de->bte', h, w_in)
    q, k, v, c_b, c_c, c_h, g_a, g_c = jnp.split(p, SPLIT_POINTS, axis=-1)
    heads = (b, t, N_GROUPS, HEADS_PER_GROUP, HEAD_DIM)
    return q.reshape(heads), k.reshape(heads), v.reshape(heads), c_b, c_c * c_h, g_a, g_c


def _band_attention(q, k, v, band):
    n, mlen, h, d = q.shape
    nb = -(-mlen // Q_BLOCK)
    pad = nb * Q_BLOCK - mlen
    qb = jnp.pad(q, ((0, 0), (0, pad), (0, 0), (0, 0))).reshape(n, nb, Q_BLOCK, h, d)

    def key_blocks(t):
        tp = jnp.pad(t, ((0, 0), (Q_BLOCK, pad), (0, 0), (0, 0))).reshape(n, nb + 1, Q_BLOCK, h, d)
        return jnp.concatenate([tp[:, :-1], tp[:, 1:]], axis=2)

    kb, vb = key_blocks(k), key_blocks(v)
    s = jnp.einsum('nbqhd,nbkhd->nbhqk', qb, kb, preferred_element_type=jnp.float32) * (d ** -0.5)
    qi = jnp.arange(Q_BLOCK)[:, None]
    ki = jnp.arange(2 * Q_BLOCK)[None, :]
    rel = qi + Q_BLOCK - ki
    kpos = jnp.arange(nb)[:, None, None] * Q_BLOCK - Q_BLOCK + ki
    valid = (rel >= 0) & (rel <= band) & (kpos >= 0)
    s = jnp.where(valid[None, :, None], s, NEG)
    m = jnp.max(s, axis=-1)
    p = jnp.exp(s - m[..., None])
    den = jnp.sum(p, axis=-1)
    o = jnp.einsum('nbhqk,nbkhd->nbqhd', p, vb.astype(jnp.float32))
    o = o / jnp.swapaxes(den, -1, -2)[..., None]
    lse = jnp.swapaxes(m + jnp.log(den), -1, -2)
    o = o.reshape(n, nb * Q_BLOCK, h, d)[:, :mlen]
    lse = lse.reshape(n, nb * Q_BLOCK, h)[:, :mlen]
    return o, lse


def _dilated_prompt(q, k, v, dil, band):
    b, s, h, d = q.shape

    def split(t):
        return t.reshape(b, s // dil, dil, h, d).transpose(0, 2, 1, 3, 4).reshape(b * dil, s // dil, h, d)

    o, lse = _band_attention(split(q), split(k), split(v), band)
    o = o.reshape(b, dil, s // dil, h, d).transpose(0, 2, 1, 3, 4).reshape(b, s, h, d)
    lse = lse.reshape(b, dil, s // dil, h).transpose(0, 2, 1, 3).reshape(b, s, h)
    return o, lse


def _dilated_sample(q, kcat, vcat, n_past, dil, band):
    t = q.shape[1]
    idx = n_past + jnp.arange(t)[:, None] - dil * jnp.arange(band + 1)[None, :]
    valid = idx >= 0
    idx = jnp.maximum(idx, 0)
    kg = kcat[:, idx]
    vg = vcat[:, idx]
    s = jnp.einsum('bthd,btjhd->bthj', q, kg, preferred_element_type=jnp.float32) * (q.shape[-1] ** -0.5)
    s = jnp.where(valid[None, :, None, :], s, NEG)
    m = jnp.max(s, axis=-1)
    p = jnp.exp(s - m[..., None])
    den = jnp.sum(p, axis=-1)
    o = jnp.einsum('bthj,btjhd->bthd', p, vg.astype(jnp.float32)) / den[..., None]
    return o, m + jnp.log(den)


def _merge_groups(outs, lses):
    o = jnp.stack(outs, axis=0)
    alpha = jax.nn.softmax(jnp.stack(lses, axis=0), axis=0)
    a = jnp.sum(alpha[..., None] * o, axis=0)
    b, t = a.shape[:2]
    return a.reshape(b, t, GROUP_WIDTH)


def _causal_conv(u_ext, w):
    t = u_ext.shape[1] - (CONV_WIDTH - 1)
    y = w[0] * u_ext[:, 0:t]
    for j in range(1, CONV_WIDTH):
        y = y + w[j] * u_ext[:, j:j + t]
    return y


def _block_output(x, attn, conv_v, c_b, g_a, g_c, w_attn_o, w_conv_o, w_o,
                  w_ff1, w_ff2, g_mix_post, g_ffn_pre, g_ffn_post):
    a = attn.astype(x.dtype) @ w_attn_o
    c = (c_b * conv_v) @ w_conv_o
    mix = (jax.nn.sigmoid(g_a) * a + jax.nn.sigmoid(g_c) * c) @ w_o
    x = x + _rms_norm(mix, g_mix_post)
    h = _rms_norm(x, g_ffn_pre)
    f = jnp.square(jax.nn.relu(h @ w_ff1)) @ w_ff2
    return x + _rms_norm(f, g_ffn_post)


def setup_inputs(seed: int = 0) -> dict:
    key = jax.random.key(seed)
    ks = jax.random.split(key, 20)
    f32 = jnp.float32
    nrm = lambda k, shape, scale: jax.random.normal(k, shape, f32) * scale
    cache_shape = lambda w: (DEPTH, DEC_BATCH, min(w, PAST_LEN), 2, HEADS_PER_GROUP, HEAD_DIM)
    return {
        "x_prompt": nrm(ks[0], (BATCH, SEQ, D_MODEL), 1.0),
        "x_sample": nrm(ks[1], (DEC_BATCH, DEC_SEQ, D_MODEL), 1.0),
        "cache_kv_w128": nrm(ks[2], cache_shape(WINDOWS[0]), 1.0),
        "cache_kv_w512": nrm(ks[3], cache_shape(WINDOWS[1]), 1.0),
        "cache_kv_w2048": nrm(ks[4], cache_shape(WINDOWS[2]), 1.0),
        "state_conv": nrm(ks[5], (DEPTH, DEC_BATCH, CONV_WIDTH - 1, D_CONV), 1.0),
        "w_in": nrm(ks[6], (DEPTH, D_MODEL, IN_WIDTH), D_MODEL ** -0.5),
        "conv_w": nrm(ks[7], (DEPTH, CONV_WIDTH, D_CONV), CONV_WIDTH ** -0.5),
        "w_attn_o": nrm(ks[8], (DEPTH, GROUP_WIDTH, D_MODEL), GROUP_WIDTH ** -0.5),
        "w_conv_o": nrm(ks[9], (DEPTH, D_CONV, D_MODEL), D_CONV ** -0.5),
        "w_o": nrm(ks[10], (DEPTH, D_MODEL, D_MODEL), D_MODEL ** -0.5),
        "w_ff1": nrm(ks[11], (DEPTH, D_MODEL, D_FF), D_MODEL ** -0.5),
        "w_ff2": nrm(ks[12], (DEPTH, D_FF, D_MODEL), D_FF ** -0.5),
        "g_mix_pre": 1.0 + nrm(ks[13], (DEPTH, D_MODEL), 0.02),
        "g_mix_post": 1.0 + nrm(ks[14], (DEPTH, D_MODEL), 0.02),
        "g_ffn_pre": 1.0 + nrm(ks[15], (DEPTH, D_MODEL), 0.02),
        "g_ffn_post": 1.0 + nrm(ks[16], (DEPTH, D_MODEL), 0.02),
    }


def reference(x_prompt, x_sample, cache_kv_w128, cache_kv_w512, cache_kv_w2048, state_conv,
              w_in, conv_w, w_attn_o, w_conv_o, w_o, w_ff1, w_ff2,
              g_mix_pre, g_mix_post, g_ffn_pre, g_ffn_post):
    caches = (cache_kv_w128, cache_kv_w512, cache_kv_w2048)
    yp, ys = x_prompt, x_sample
    kv_p = [[] for _ in range(N_GROUPS)]
    kv_s = [[] for _ in range(N_GROUPS)]
    conv_p, conv_s = [], []
    for l in range(DEPTH):
        h = _rms_norm(yp, g_mix_pre[l])
        q, k, v, c_b, u, g_a, g_c = _project(h, w_in[l])
        outs, lses = [], []
        for g in range(N_GROUPS):
            o, lse = _dilated_prompt(q[:, :, g], k[:, :, g], v[:, :, g],
                                     DILATIONS[g], WINDOWS[g] // DILATIONS[g])
            outs.append(o)
            lses.append(lse)
            kv = jnp.stack([k[:, :, g], v[:, :, g]], axis=2)
            kv_p[g].append(kv[:, -min(WINDOWS[g], kv.shape[1]):])
        u_ext = jnp.pad(u, ((0, 0), (CONV_WIDTH - 1, 0), (0, 0)))
        conv_v = _causal_conv(u_ext, conv_w[l])
        conv_p.append(u_ext[:, -(CONV_WIDTH - 1):])
        yp = _block_output(yp, _merge_groups(outs, lses), conv_v, c_b, g_a, g_c,
                           w_attn_o[l], w_conv_o[l], w_o[l], w_ff1[l], w_ff2[l],
                           g_mix_post[l], g_ffn_pre[l], g_ffn_post[l])

        h = _rms_norm(ys, g_mix_pre[l])
        q, k, v, c_b, u, g_a, g_c = _project(h, w_in[l])
        outs, lses = [], []
        for g in range(N_GROUPS):
            buf = caches[g][l]
            n_past = buf.shape[1]
            cat = jnp.concatenate([buf, jnp.stack([k[:, :, g], v[:, :, g]], axis=2).astype(buf.dtype)], axis=1)
            o, lse = _dilated_sample(q[:, :, g], cat[:, :, 0], cat[:, :, 1], n_past,
                                     DILATIONS[g], WINDOWS[g] // DILATIONS[g])
            outs.append(o)
            lses.append(lse)
            kv_s[g].append(cat[:, -n_past:])
        u_ext = jnp.concatenate([state_conv[l].astype(u.dtype), u], axis=1)
        conv_v = _causal_conv(u_ext, conv_w[l])
        conv_s.append(u_ext[:, -(CONV_WIDTH - 1):])
        ys = _block_output(ys, _merge_groups(outs, lses), conv_v, c_b, g_a, g_c,
                           w_attn_o[l], w_conv_o[l], w_o[l], w_ff1[l], w_ff2[l],
                           g_mix_post[l], g_ffn_pre[l], g_ffn_post[l])

    kv_w128_prompt = jnp.stack(kv_p[0], axis=0)
    kv_w512_prompt = jnp.stack(kv_p[1], axis=0)
    kv_w2048_prompt = jnp.stack(kv_p[2], axis=0)
    conv_prompt = jnp.stack(conv_p, axis=0)
    kv_w128_sample = jnp.stack(kv_s[0], axis=0)
    kv_w512_sample = jnp.stack(kv_s[1], axis=0)
    kv_w2048_sample = jnp.stack(kv_s[2], axis=0)
    conv_sample = jnp.stack(conv_s, axis=0)
    return (yp, ys, kv_w128_prompt, kv_w512_prompt, kv_w2048_prompt, conv_prompt,
            kv_w128_sample, kv_w512_sample, kv_w2048_sample, conv_sample)
```

```cpp
#include <hip/hip_runtime.h>
#include <hip/hip_cooperative_groups.h>
#include <cstdio>
#include <cstdint>
namespace cg = cooperative_groups;
namespace pg8 {
#define PG8_LAS __attribute__((address_space(3)))
typedef unsigned short bf16_t;
typedef short bf16x8 __attribute__((ext_vector_type(8)));
typedef float f32x4 __attribute__((ext_vector_type(4)));
typedef unsigned u32x4 __attribute__((ext_vector_type(4)));
constexpr int BM = 256, BK = 64, HALF = 128, HTB = HALF * BK * 2  , STAGE_BYTES = 8 * HTB, NXCD = 8, WGM = 8;

__host__ __device__ __forceinline__ int lds_byte(int r, int c) { const int st = (r >> 4) * 2 + (c >> 5), rr = r & 15, cc = c & 31, ob = rr * 64 + cc * 2; return st * 1024 + (ob ^ (((ob >> 9) & 1) << 5)); }
__host__ __device__ __forceinline__ void stage_rc(int b, int& R, int& C) { const int st = b / 1024, sb = b % 1024, swz = sb ^ (((sb >> 9) & 1) << 5); R = (st >> 1) * 16 + swz / 64; C = (st & 1) * 32 + (swz % 64) / 2; }
__host__ __device__ __forceinline__ int perm32(int rho) { const int n = rho >> 4, i = rho & 15; return 8 * (i >> 2) + 4 * n + (i & 3); }

struct Unit { int pm, pn; };
struct Gemm { const bf16_t* A; const bf16_t* Bt; int M, N, K; };

struct StaticOrder {
    int nM, nN, nwg, G, c;
    __host__ __device__ void init(int M, int N, int G_, int c_) { nM = M / BM; nN = N / BM; nwg = nM * nN; G = G_; c = c_; }
    __host__ __device__ bool next(int i, Unit& u) const {
        const long L = (long)i * G + c; if (L >= nwg) return false;
        int wgid = (int)L; { const int q = nwg / NXCD, r = nwg % NXCD, xcd = wgid % NXCD, off = wgid / NXCD; wgid = (xcd < r ? xcd * (q + 1) : r * (q + 1) + (xcd - r) * q) + off; }
        const int nig = WGM * nN, gid = wgid / nig, fm = gid * WGM, gsz = (nM - fm) < WGM ? (nM - fm) : WGM;
        u.pm = fm + ((wgid % nig) % gsz); u.pn = (wgid % nig) / gsz; return true;
    }
    __device__ __forceinline__ void a_ready(const Unit&) const {}
    __device__ __forceinline__ void done(const Unit&) const {}
};
__device__ __forceinline__ unsigned cvt_pk_bf16(float lo, float hi) { unsigned r; asm volatile("v_cvt_pk_bf16_f32 %0, %1, %2" : "=v"(r) : "v"(lo), "v"(hi)); return r; }
template <class Epi, class Sched, bool ALIGN_EPI = false, bool SP2 = false>
__device__ __forceinline__ void gemm_phase(PG8_LAS unsigned char* lds, const Gemm g, const Sched& S, const Epi& E) {
    int tid_ = threadIdx.x; asm volatile("" : "+v"(tid_));
    const int tid = tid_, wid = __builtin_amdgcn_readfirstlane(tid >> 6), lane = tid & 63, wr = wid >> 2, wc = wid & 3, fr = lane & 15, fq = lane >> 4;
    const int K = g.K, nt = K / BK;
    unsigned voffA[2], voffB[2];
#pragma unroll
    for (int i = 0; i < 2; ++i) { int R, C; stage_rc(tid * 16 + i * 8192, R, C); const int Rb = Epi::PERM ? ((R & ~31) + perm32(R & 31)) : R;
        voffA[i] = (unsigned)(R * K + C) * 2u; voffB[i] = (unsigned)(Rb * K + C) * 2u; }
    const size_t kstep = (size_t)(BK * 2);
    const size_t hstep = (size_t)HALF * K * 2;
    const size_t tstep = 2 * hstep;
    const unsigned ldsw = (unsigned)wid * 1024u;
    const int aoff = lds_byte(wr * 64 + fr, fq * 8), boff = lds_byte(wc * 32 + fr, fq * 8);
#define PG8_SA(b, h) (((b) * 2 + (h)) * HTB)
#define PG8_SB(b, h) ((4 + (b) * 2 + (h)) * HTB)
#define PG8_STAGE(bufoff, gbase, voff) do { _Pragma("unroll") for (int _i = 0; _i < 2; ++_i) \
        __builtin_amdgcn_global_load_lds((const unsigned*)((const char*)(gbase) + (voff)[_i]), (PG8_LAS unsigned*)(lds + (bufoff) + ldsw + _i * 8192), 16, 0, 0); } while (0)
#define PG8_LDA(dst, b, h) do { _Pragma("unroll") for (int m = 0; m < 4; ++m) _Pragma("unroll") for (int k = 0; k < 2; ++k) dst[m][k] = *(const PG8_LAS bf16x8*)(lds + PG8_SA(b, h) + aoff + m * 2048 + k * 1024); } while (0)
#define PG8_LDB(dst, b, h) do { _Pragma("unroll") for (int n = 0; n < 2; ++n) _Pragma("unroll") for (int k = 0; k < 2; ++k) dst[n][k] = *(const PG8_LAS bf16x8*)(lds + PG8_SB(b, h) + boff + n * 2048 + k * 1024); } while (0)
#define PG8_MMA(ai, bj, At, Bt) do { __builtin_amdgcn_s_setprio(1); _Pragma("unroll") for (int m = 0; m < 4; ++m) _Pragma("unroll") for (int n = 0; n < 2; ++n) _Pragma("unroll") for (int k = 0; k < 2; ++k) \
        acc[ai][bj][m][n] = __builtin_amdgcn_mfma_f32_16x16x32_bf16(Bt[n][k], At[m][k], acc[ai][bj][m][n], 0, 0, 0); __builtin_amdgcn_s_setprio(0); } while (0)
#define PG8_WAIT_V(n) asm volatile("s_waitcnt vmcnt(" #n ")" ::: "memory")
#define PG8_WAIT_L(n) asm volatile("s_waitcnt lgkmcnt(" #n ")" ::: "memory")
#define PG8_BAR __builtin_amdgcn_s_barrier()
#define PG8_SCHED __builtin_amdgcn_sched_barrier(0)
    Unit cur, nxt; int ui = 0;
    if (!S.next(0, cur)) return;
    f32x4 acc[2][2][4][2];
#pragma unroll
    for (int a = 0; a < 2; ++a)
#pragma unroll
        for (int b = 0; b < 2; ++b)
#pragma unroll
            for (int m = 0; m < 4; ++m)
#pragma unroll
                for (int n = 0; n < 2; ++n) acc[a][b][m][n] = (f32x4){0.f, 0.f, 0.f, 0.f};
    bf16x8 At[4][2], B0[2][2], B1[2][2];
    const char* cA = (const char*)g.A + (size_t)cur.pm * tstep; const char* cB = (const char*)g.Bt + (size_t)cur.pn * tstep;
    S.a_ready(cur);
    if constexpr (SP2) {
        PG8_STAGE(PG8_SB(0, 0), cB, voffB); PG8_STAGE(PG8_SB(0, 1), cB + hstep, voffB); PG8_STAGE(PG8_SA(0, 0), cA, voffA); PG8_STAGE(PG8_SA(0, 1), cA + hstep, voffA);
        if (wr == 1) PG8_BAR;
        PG8_WAIT_V(2); PG8_BAR;
        PG8_STAGE(PG8_SB(1, 0), cB + kstep, voffB); PG8_STAGE(PG8_SA(1, 0), cA + kstep, voffA); PG8_STAGE(PG8_SB(1, 1), cB + hstep + kstep, voffB);
        PG8_WAIT_V(6); PG8_BAR;
    } else {
        PG8_STAGE(PG8_SB(0, 0), cB, voffB); PG8_STAGE(PG8_SA(0, 0), cA, voffA); PG8_STAGE(PG8_SB(0, 1), cB + hstep, voffB); PG8_STAGE(PG8_SA(0, 1), cA + hstep, voffA);
        if (wr == 1) PG8_BAR;
        PG8_WAIT_V(4); PG8_BAR;
        PG8_STAGE(PG8_SB(1, 0), cB + kstep, voffB); PG8_STAGE(PG8_SA(1, 0), cA + kstep, voffA); PG8_STAGE(PG8_SB(1, 1), cB + hstep + kstep, voffB);
        PG8_WAIT_V(6); PG8_BAR;
    }
    for (;;) {
        const bool has_next = S.next(ui + 1, nxt);
        const char* nA = has_next ? (const char*)g.A + (size_t)nxt.pm * tstep : cA; const char* nB = has_next ? (const char*)g.Bt + (size_t)nxt.pn * tstep : cB;
        for (int t = 0; t < nt; t += 2) {
            const bool last = (t == nt - 2);
            const char* a1 = cA + (size_t)(t + 1) * kstep;
            const char* a2 = last ? nA : cA + (size_t)(t + 2) * kstep; const char* b2 = last ? nB : cB + (size_t)(t + 2) * kstep;
            const char* a3 = a2 + kstep; const char* b3 = b2 + kstep;
            if (last && has_next) S.a_ready(nxt);
            if constexpr (SP2) {
            PG8_LDB(B0, 0, 0); PG8_LDB(B1, 0, 1); PG8_SCHED; PG8_LDA(At, 0, 0); PG8_STAGE(PG8_SA(1, 1), a1 + hstep, voffA);
            PG8_WAIT_V(8); PG8_WAIT_L(0); PG8_BAR; PG8_MMA(0, 0, At, B0); PG8_MMA(0, 1, At, B1); PG8_BAR; PG8_SCHED;
            PG8_LDA(At, 0, 1); PG8_STAGE(PG8_SB(0, 0), b2, voffB); PG8_STAGE(PG8_SB(0, 1), b2 + hstep, voffB); PG8_STAGE(PG8_SA(0, 0), a2, voffA);
            PG8_WAIT_V(8); PG8_WAIT_L(0); PG8_BAR; PG8_MMA(1, 0, At, B0); PG8_MMA(1, 1, At, B1); PG8_BAR; PG8_SCHED;
            PG8_LDB(B0, 1, 0); PG8_LDB(B1, 1, 1); PG8_SCHED; PG8_LDA(At, 1, 0); PG8_STAGE(PG8_SA(0, 1), a2 + hstep, voffA);
            PG8_WAIT_V(8); PG8_WAIT_L(0); PG8_BAR; PG8_MMA(0, 0, At, B0); PG8_MMA(0, 1, At, B1); PG8_BAR; PG8_SCHED;
            PG8_LDA(At, 1, 1); PG8_STAGE(PG8_SB(1, 0), b3, voffB); PG8_STAGE(PG8_SB(1, 1), b3 + hstep, voffB); PG8_STAGE(PG8_SA(1, 0), a3, voffA);
            PG8_WAIT_V(8); PG8_WAIT_L(0); PG8_BAR; PG8_MMA(1, 0, At, B0); PG8_MMA(1, 1, At, B1); PG8_BAR; PG8_SCHED;
            } else {
            PG8_LDB(B0, 0, 0); PG8_SCHED; PG8_LDA(At, 0, 0); PG8_STAGE(PG8_SA(1, 1), a1 + hstep, voffA);
            PG8_WAIT_L(8); PG8_BAR; PG8_WAIT_L(0); PG8_MMA(0, 0, At, B0); PG8_BAR; PG8_SCHED;
            PG8_LDB(B1, 0, 1); PG8_STAGE(PG8_SB(0, 0), b2, voffB);
            PG8_BAR; PG8_WAIT_L(0); PG8_MMA(0, 1, At, B1); PG8_BAR;
            PG8_LDA(At, 0, 1); PG8_STAGE(PG8_SA(0, 0), a2, voffA);
            PG8_BAR; PG8_WAIT_L(0); PG8_MMA(1, 0, At, B0); PG8_BAR; PG8_SCHED;
            PG8_STAGE(PG8_SB(0, 1), b2 + hstep, voffB);
            PG8_WAIT_V(6); PG8_BAR; PG8_MMA(1, 1, At, B1); PG8_BAR;
            PG8_LDB(B0, 1, 0); PG8_SCHED; PG8_LDA(At, 1, 0); PG8_STAGE(PG8_SA(0, 1), a2 + hstep, voffA);
            PG8_WAIT_L(8); PG8_BAR; PG8_WAIT_L(0); PG8_MMA(0, 0, At, B0); PG8_BAR; PG8_SCHED;
            PG8_LDB(B1, 1, 1); PG8_STAGE(PG8_SB(1, 0), b3, voffB);
            PG8_BAR; PG8_WAIT_L(0); PG8_MMA(0, 1, At, B1); PG8_BAR;
            PG8_LDA(At, 1, 1); PG8_STAGE(PG8_SA(1, 0), a3, voffA);
            PG8_BAR; PG8_WAIT_L(0); PG8_MMA(1, 0, At, B0); PG8_BAR; PG8_SCHED;
            PG8_STAGE(PG8_SB(1, 1), b3 + hstep, voffB);
            PG8_WAIT_V(6); PG8_BAR; PG8_MMA(1, 1, At, B1); PG8_BAR;
            }
        }
        if constexpr (ALIGN_EPI) { if (wr == 0) PG8_BAR; }
        if constexpr (!Epi::AFTER_DRAIN) { E(acc, cur, wr, wc, fr, fq); S.done(cur); }
        if (!has_next) break;
#pragma unroll
        for (int a = 0; a < 2; ++a)
#pragma unroll
            for (int b = 0; b < 2; ++b)
#pragma unroll
                for (int m = 0; m < 4; ++m)
#pragma unroll
                    for (int n = 0; n < 2; ++n) acc[a][b][m][n] = (f32x4){0.f, 0.f, 0.f, 0.f};
        cur = nxt; cA = nA; cB = nB; ++ui;
        if constexpr (ALIGN_EPI) { if (wr == 1) PG8_BAR; }
    }
    PG8_WAIT_V(0);
    if constexpr (!ALIGN_EPI) { if (wr == 0) PG8_BAR; }
    PG8_BAR;
    if constexpr (Epi::AFTER_DRAIN) { E.fused(acc, cur, wr, wc, fr, fq, lds, wid, lane); S.done(cur); }
#undef PG8_SA
#undef PG8_SB
#undef PG8_STAGE
#undef PG8_LDA
#undef PG8_LDB
#undef PG8_MMA
#undef PG8_WAIT_V
#undef PG8_WAIT_L
#undef PG8_BAR
#undef PG8_SCHED
}
}

#define LAS __attribute__((address_space(3)))
typedef unsigned short bf16_t;
typedef float f32x4 __attribute__((ext_vector_type(4)));
typedef float f32x16 __attribute__((ext_vector_type(16)));
typedef unsigned u32x4 __attribute__((ext_vector_type(4)));
typedef unsigned u32x2 __attribute__((ext_vector_type(2)));
typedef short bf16x8 __attribute__((ext_vector_type(8)));
typedef short s16x4 __attribute__((ext_vector_type(4)));

constexpr int NP = 16384, NS = 32, MPAD = 16640, DM = 1024, INW = 9728, DFF = 4096, RQ = 16640, PCW = 5120;
constexpr float EPS = 1e-6f;
constexpr float C2 = 0.125f * 1.4426950408889634f;
constexpr int LDS_BYTES = 131072 + 256;
constexpr int NTHREADS = 512;

constexpr size_t O_YP = 0, O_YS = 16777216, O_KV128P = 16809984, O_KV512P = 17072128, O_KV2048P = 18120704, O_CONVP = 22315008,
                 O_KV128S = 22319104, O_KV512S = 26513408, O_KV2048S = 43290624, O_CONVS = 110399488;

constexpr size_t WS_WIN = 0;
constexpr size_t WS_WAO = WS_WIN + (size_t)INW * DM * 2;
constexpr size_t WS_WCO = WS_WAO + (size_t)DM * 512 * 2;
constexpr size_t WS_WO = WS_WCO + (size_t)DM * DM * 2;
constexpr size_t WS_WF1 = WS_WO + (size_t)DM * DM * 2;
constexpr size_t WS_WF2 = WS_WF1 + (size_t)DFF * DM * 2;
constexpr size_t WS_H = WS_WF2 + (size_t)DFF * DM * 2;
constexpr size_t QKV_SZ = (size_t)24 * RQ * 64 * 2;
constexpr size_t WS_Q = WS_H + (size_t)MPAD * DM * 2;
constexpr size_t WS_K = WS_Q + QKV_SZ, WS_V = WS_K + QKV_SZ;
constexpr size_t WS_HID = WS_Q;
constexpr size_t WS_PC = WS_V + QKV_SZ;
constexpr size_t WS_OG = WS_PC + (size_t)MPAD * PCW * 2;
constexpr size_t WS_LSE = WS_OG + (size_t)3 * NP * 512 * 2;
constexpr size_t WS_ATTN = WS_LSE + (size_t)3 * NP * 8 * 4;
constexpr size_t WS_CV = WS_ATTN + (size_t)MPAD * 512 * 2;
constexpr size_t WS_T = WS_CV + (size_t)MPAD * DM * 2;
constexpr size_t WS_MIXIN = WS_T + (size_t)MPAD * DM * 4;
constexpr size_t WS_MIX = WS_MIXIN + (size_t)MPAD * DM * 2;
constexpr size_t WS_H2 = WS_MIX + (size_t)MPAD * DM * 2;
constexpr size_t WS_F = WS_H2 + (size_t)MPAD * DM * 2;
constexpr size_t WS_SS = WS_F + (size_t)MPAD * DM * 2;
constexpr size_t WS_BAR = WS_SS + (size_t)2 * MPAD * 4;
constexpr size_t WS_SO = WS_BAR + 16384;
constexpr size_t WS_END = WS_SO + (size_t)(768 * 64 + 768) * 4;
static_assert((size_t)MPAD * DFF * 2 <= 3 * QKV_SZ, "hid overlay");

__device__ __forceinline__ unsigned pk_bf16(float lo, float hi) { return pg8::cvt_pk_bf16(lo, hi); }
__device__ __forceinline__ float bf_lo(unsigned w) { return __uint_as_float(w << 16); }
__device__ __forceinline__ float bf_hi(unsigned w) { return __uint_as_float(w & 0xffff0000u); }
__device__ __forceinline__ float bf2f(bf16_t v) { return __uint_as_float((unsigned)v << 16); }
__device__ __forceinline__ float sigm(float x) { return 1.f / (1.f + __expf(-x)); }
__device__ __forceinline__ void unpack8(const u32x4 w, float (&f)[8]) {
    f[0] = bf_lo(w.x); f[1] = bf_hi(w.x); f[2] = bf_lo(w.y); f[3] = bf_hi(w.y); f[4] = bf_lo(w.z); f[5] = bf_hi(w.z); f[6] = bf_lo(w.w); f[7] = bf_hi(w.w);
}
__device__ __forceinline__ u32x4 pack8(const float (&f)[8]) {
    u32x4 w; w.x = pk_bf16(f[0], f[1]); w.y = pk_bf16(f[2], f[3]); w.z = pk_bf16(f[4], f[5]); w.w = pk_bf16(f[6], f[7]); return w;
}
__device__ __forceinline__ float wave_sum(float v) {
#pragma unroll
    for (int o = 1; o < 64; o <<= 1) v += __shfl_xor(v, o);
    return v;
}
__device__ __forceinline__ float wave_max(float v) {
#pragma unroll
    for (int o = 1; o < 64; o <<= 1) v = fmaxf(v, __shfl_xor(v, o));
    return v;
}

struct EpiIn {
    static constexpr bool PERM = true, AFTER_DRAIN = false;
    bf16_t *Q, *PC;
    __device__ __forceinline__ void operator()(const f32x4 (&acc)[2][2][4][2], const pg8::Unit& u, int wr, int wc, int fr, int fq) const {
        const int colt = u.pn * 256, row0 = u.pm * 256 + wr * 64 + fr;
        if (colt < 4608) {
            const int which = colt / 1536, cin = colt - which * 1536;
            bf16_t* base = Q + (size_t)which * (QKV_SZ / 2);
            const int g = cin >> 9, sh = 2 * g;
#pragma unroll
            for (int ai = 0; ai < 2; ++ai)
#pragma unroll
                for (int m = 0; m < 4; ++m) {
                    const int row = row0 + ai * 128 + m * 16;
                    const int rowp = row < NP ? ((row & ~8191) | ((row & ((1 << sh) - 1)) << (13 - sh)) | ((row & 8191) >> sh)) : row;
#pragma unroll
                    for (int bj = 0; bj < 2; ++bj) {
                        const int cgc = cin + bj * 128 + wc * 32 + 8 * fq, h = (cgc >> 6) & 7, d = cgc & 63;
                        const f32x4 v0 = acc[ai][bj][m][0], v1 = acc[ai][bj][m][1];
                        u32x4 w; w.x = pk_bf16(v0[0], v0[1]); w.y = pk_bf16(v0[2], v0[3]); w.z = pk_bf16(v1[0], v1[1]); w.w = pk_bf16(v1[2], v1[3]);
                        *(u32x4*)(base + ((size_t)(g * 8 + h) * RQ + rowp) * 64 + d) = w;
                    }
                }
        } else {
            const int c0 = colt - 4608 + wc * 32 + 8 * fq;
#pragma unroll
            for (int ai = 0; ai < 2; ++ai)
#pragma unroll
                for (int m = 0; m < 4; ++m) {
                    bf16_t* rowp = PC + (size_t)(row0 + ai * 128 + m * 16) * PCW + c0;
#pragma unroll
                    for (int bj = 0; bj < 2; ++bj) {
                        const f32x4 v0 = acc[ai][bj][m][0], v1 = acc[ai][bj][m][1];
                        u32x4 w; w.x = pk_bf16(v0[0], v0[1]); w.y = pk_bf16(v0[2], v0[3]); w.z = pk_bf16(v1[0], v1[1]); w.w = pk_bf16(v1[2], v1[3]);
                        *(u32x4*)(rowp + bj * 128) = w;
                    }
                }
        }
    }
};

struct EpiGateA {
    static constexpr bool PERM = true, AFTER_DRAIN = false;
    const bf16_t* PC; bf16_t* T;
    __device__ __forceinline__ void operator()(const f32x4 (&acc)[2][2][4][2], const pg8::Unit& u, int wr, int wc, int fr, int fq) const {
        const int row0 = u.pm * 256 + wr * 64 + fr, col0 = u.pn * 256 + wc * 32 + 8 * fq;
#pragma unroll
        for (int ai = 0; ai < 2; ++ai)
#pragma unroll
            for (int m = 0; m < 4; ++m) {
                const int row = row0 + ai * 128 + m * 16;
#pragma unroll
                for (int bj = 0; bj < 2; ++bj) {
                    const int col = col0 + bj * 128;
                    float gt[8]; unpack8(*(const u32x4*)(PC + (size_t)row * PCW + 3072 + col), gt);
                    const f32x4 v0 = acc[ai][bj][m][0], v1 = acc[ai][bj][m][1];
                    float o[8];
#pragma unroll
                    for (int j = 0; j < 4; ++j) { o[j] = sigm(gt[j]) * v0[j]; o[4 + j] = sigm(gt[4 + j]) * v1[j]; }
                    *(u32x4*)(T + (size_t)row * DM + col) = pack8(o);
                }
            }
    }
};

struct EpiGateC {
    static constexpr bool PERM = true, AFTER_DRAIN = false;
    const bf16_t* PC; const bf16_t* T; bf16_t* O;
    __device__ __forceinline__ void operator()(const f32x4 (&acc)[2][2][4][2], const pg8::Unit& u, int wr, int wc, int fr, int fq) const {
        const int row0 = u.pm * 256 + wr * 64 + fr, col0 = u.pn * 256 + wc * 32 + 8 * fq;
#pragma unroll
        for (int ai = 0; ai < 2; ++ai)
#pragma unroll
            for (int m = 0; m < 4; ++m) {
                const int row = row0 + ai * 128 + m * 16;
#pragma unroll
                for (int bj = 0; bj < 2; ++bj) {
                    const int col = col0 + bj * 128;
                    float gt[8]; unpack8(*(const u32x4*)(PC + (size_t)row * PCW + 4096 + col), gt);
                    float tt[8]; unpack8(*(const u32x4*)(T + (size_t)row * DM + col), tt);
                    const f32x4 v0 = acc[ai][bj][m][0], v1 = acc[ai][bj][m][1];
                    float o[8];
#pragma unroll
                    for (int j = 0; j < 4; ++j) { o[j] = tt[j] + sigm(gt[j]) * v0[j]; o[4 + j] = tt[4 + j] + sigm(gt[4 + j]) * v1[j]; }
                    *(u32x4*)(O + (size_t)row * DM + col) = pack8(o);
                }
            }
    }
};

struct EpiSS {
    static constexpr bool PERM = true, AFTER_DRAIN = false;
    bf16_t* O; float* ss;
    __device__ __forceinline__ void operator()(const f32x4 (&acc)[2][2][4][2], const pg8::Unit& u, int wr, int wc, int fr, int fq) const {
        const int row0 = u.pm * 256 + wr * 64 + fr, col0 = u.pn * 256 + wc * 32 + 8 * fq;
#pragma unroll
        for (int ai = 0; ai < 2; ++ai)
#pragma unroll
            for (int m = 0; m < 4; ++m) {
                const int row = row0 + ai * 128 + m * 16;
                float s = 0.f;
#pragma unroll
                for (int bj = 0; bj < 2; ++bj) {
                    const f32x4 v0 = acc[ai][bj][m][0], v1 = acc[ai][bj][m][1];
                    u32x4 w; w.x = pk_bf16(v0[0], v0[1]); w.y = pk_bf16(v0[2], v0[3]); w.z = pk_bf16(v1[0], v1[1]); w.w = pk_bf16(v1[2], v1[3]);
                    *(u32x4*)(O + (size_t)row * DM + col0 + bj * 128) = w;
#pragma unroll
                    for (int j = 0; j < 4; ++j) s += v0[j] * v0[j] + v1[j] * v1[j];
                }
                s += __shfl_xor(s, 16); s += __shfl_xor(s, 32);
                if (fq == 0) atomicAdd(ss + row, s);
            }
    }
};

struct EpiRelu2 {
    static constexpr bool PERM = true, AFTER_DRAIN = false;
    bf16_t* O;
    __device__ __forceinline__ void operator()(const f32x4 (&acc)[2][2][4][2], const pg8::Unit& u, int wr, int wc, int fr, int fq) const {
        const int row0 = u.pm * 256 + wr * 64 + fr, col0 = u.pn * 256 + wc * 32 + 8 * fq;
#pragma unroll
        for (int ai = 0; ai < 2; ++ai)
#pragma unroll
            for (int m = 0; m < 4; ++m) {
                bf16_t* rowp = O + (size_t)(row0 + ai * 128 + m * 16) * DFF + col0;
#pragma unroll
                for (int bj = 0; bj < 2; ++bj) {
                    f32x4 v0 = acc[ai][bj][m][0], v1 = acc[ai][bj][m][1];
#pragma unroll
                    for (int j = 0; j < 4; ++j) { const float a = fmaxf(v0[j], 0.f), b = fmaxf(v1[j], 0.f); v0[j] = a * a; v1[j] = b * b; }
                    u32x4 w; w.x = pk_bf16(v0[0], v0[1]); w.y = pk_bf16(v0[2], v0[3]); w.z = pk_bf16(v1[0], v1[1]); w.w = pk_bf16(v1[2], v1[3]);
                    *(u32x4*)(rowp + bj * 128) = w;
                }
            }
    }
};

__device__ __forceinline__ void transpose_item(const float* W, int K, int N, bf16_t* WT, LAS float* scr, int item, int lane) {
    const int nblk = N >> 5, kb = item / nblk, nb = item - kb * nblk, k0 = 64 * kb, n0 = 32 * nb;
#pragma unroll 8
    for (int i = 0; i < 32; ++i) { const int kk = 2 * i + (lane >> 5); scr[kk * 33 + (lane & 31)] = W[(size_t)(k0 + kk) * N + n0 + (lane & 31)]; }
    asm volatile("s_waitcnt lgkmcnt(0)" ::: "memory");
    const int c = lane & 7;
#pragma unroll
    for (int j = 0; j < 4; ++j) {
        const int n = (lane >> 3) + 8 * j; const LAS float* s = scr + (8 * c) * 33 + n;
        u32x4 o; o.x = pk_bf16(s[0 * 33], s[1 * 33]); o.y = pk_bf16(s[2 * 33], s[3 * 33]); o.z = pk_bf16(s[4 * 33], s[5 * 33]); o.w = pk_bf16(s[6 * 33], s[7 * 33]);
        *(u32x4*)(WT + (size_t)(n0 + n) * K + k0 + 8 * c) = o;
    }
    asm volatile("s_waitcnt lgkmcnt(0)" ::: "memory");
}

__device__ __forceinline__ void rms_row_bf16(const float* xrow, const float* g, bf16_t* orow, int lane) {
    const f32x4* xr = (const f32x4*)xrow + lane; f32x4 v[4]; float s = 0.f;
#pragma unroll
    for (int j = 0; j < 4; ++j) { v[j] = xr[64 * j]; s += (v[j].x * v[j].x + v[j].y * v[j].y) + (v[j].z * v[j].z + v[j].w * v[j].w); }
    const float rs = rsqrtf(wave_sum(s) * (1.f / DM) + EPS);
#pragma unroll
    for (int j = 0; j < 4; ++j) {
        const f32x4 gg = ((const f32x4*)g)[lane + 64 * j];
        u32x2 o; o.x = pk_bf16(v[j].x * rs * gg.x, v[j].y * rs * gg.y); o.y = pk_bf16(v[j].z * rs * gg.z, v[j].w * rs * gg.w);
        ((u32x2*)orow)[lane + 64 * j] = o;
    }
}

__device__ __forceinline__ void shift_copy(const float* src, float* dst, int L, size_t gtid, size_t gthreads) {
    const size_t per_b = (size_t)L * 256, total = 32 * per_b, valid = (size_t)(L - 1) * 256;
    const f32x4* s4 = (const f32x4*)src; f32x4* d4 = (f32x4*)dst;
#pragma unroll 4
    for (size_t i = gtid; i < total; i += gthreads) {
        const size_t rem = i & (per_b - 1);
        if (rem < valid) { const f32x4 v = __builtin_nontemporal_load(s4 + i + 256); __builtin_nontemporal_store(v, d4 + i); }
    }
}

__device__ __forceinline__ s16x4 vtr(const LAS unsigned char* p) {
    typedef short v4i16_t __attribute__((ext_vector_type(4)));
    return __builtin_bit_cast(s16x4, __builtin_amdgcn_ds_read_tr16_b64_v4i16((LAS v4i16_t*)p));
}
__device__ __forceinline__ int crow(int r, int hi) { return (r & 3) + 8 * (r >> 2) + 4 * hi; }

__device__ __forceinline__ void attn_prompt_task(int task, const bf16_t* Qb, const bf16_t* Kb, const bf16_t* Vb, bf16_t* OG, float* LSE, LAS unsigned char* wl, int lane) {
    const int gh = task >> 9, blk = task & 511, g = gh >> 3, h = gh & 7, sh = 2 * g;
    const int R0 = blk << 5, b = R0 >> 13, off = R0 & 8191, lrb = 13 - sh;
    const int c = off >> lrb, m0 = off & ((1 << lrb) - 1);
    const int qi = lane & 31, hi = lane >> 5;
    const size_t hb = (size_t)gh * RQ;
    bf16x8 qf[4];
    { const bf16_t* qp = Qb + (hb + R0 + qi) * 64 + hi * 8;
#pragma unroll
      for (int ks = 0; ks < 4; ++ks) qf[ks] = *(const bf16x8*)(qp + ks * 16); }
    const int jfirst = m0 >= 128 ? 0 : ((128 - m0) >> 5);
    f32x16 O0, O1;
#pragma unroll
    for (int i = 0; i < 16; ++i) { O0[i] = 0.f; O1[i] = 0.f; }
    float m_run = -1e30f, l_run = 0.f;
    const int kwo = (lane >> 3) * 144 + (lane & 7) * 16;
    const int vwo = 4608 + ((lane & 7) >> 2) * 2048 + (lane >> 3) * 64 + (lane & 3) * 16;
    const int kro = qi * 144 + hi * 16;
    const int vro = 4608 + (4 * hi + ((lane & 15) >> 2)) * 64 + ((lane >> 4) & 1) * 32 + (lane & 3) * 8;
    u32x4 krA[4], vrA[4], krB[4], vrB[4];
    const size_t eb = (hb + (size_t)(R0 - 128)) * 64 + lane * 8;
    {
#pragma unroll
        for (int it = 0; it < 4; ++it) { krA[it] = *(const u32x4*)(Kb + eb + (size_t)jfirst * 2048 + it * 512); vrA[it] = *(const u32x4*)(Vb + eb + (size_t)jfirst * 2048 + it * 512); }
        if (jfirst < 4) {
#pragma unroll
            for (int it = 0; it < 4; ++it) { krB[it] = *(const u32x4*)(Kb + eb + (size_t)(jfirst + 1) * 2048 + it * 512); vrB[it] = *(const u32x4*)(Vb + eb + (size_t)(jfirst + 1) * 2048 + it * 512); }
        }
    }
#define ATT_BLOCK(J, KR, VR) do { const int j = (J); \
        asm volatile("" ::: "memory"); \
        _Pragma("unroll") for (int it = 0; it < 4; ++it) { *(LAS u32x4*)(wl + kwo + it * 8 * 144) = KR[it]; *(LAS u32x4*)(wl + vwo + it * 8 * 64) = VR[it]; } \
        asm volatile("" ::: "memory"); \
        if (j + 2 < 5) { _Pragma("unroll") for (int it = 0; it < 4; ++it) { KR[it] = *(const u32x4*)(Kb + eb + (size_t)(j + 2) * 2048 + it * 512); VR[it] = *(const u32x4*)(Vb + eb + (size_t)(j + 2) * 2048 + it * 512); } } \
        f32x16 S; \
        _Pragma("unroll") for (int i = 0; i < 16; ++i) S[i] = 0.f; \
        _Pragma("unroll") for (int ks = 0; ks < 4; ++ks) { const bf16x8 kf = *(const LAS bf16x8*)(wl + kro + ks * 32); S = __builtin_amdgcn_mfma_f32_32x32x16_bf16(kf, qf[ks], S, 0, 0, 0); } \
        float mx = -1e30f; \
        _Pragma("unroll") for (int i = 0; i < 16; ++i) { const int kk = crow(i, hi); float sv = S[i] * C2; if (j == 0 && kk < qi) sv = -1e30f; if (j == 4 && kk > qi) sv = -1e30f; S[i] = sv; mx = fmaxf(mx, sv); } \
        mx = fmaxf(mx, __shfl_xor(mx, 32)); \
        const float m_new = fmaxf(m_run, mx), corr = __builtin_amdgcn_exp2f(m_run - m_new); \
        float ps = 0.f; \
        _Pragma("unroll") for (int i = 0; i < 16; ++i) { const float p = __builtin_amdgcn_exp2f(S[i] - m_new); S[i] = p; ps += p; } \
        l_run = l_run * corr + ps; m_run = m_new; \
        _Pragma("unroll") for (int i = 0; i < 16; ++i) { O0[i] *= corr; O1[i] *= corr; } \
        bf16x8 pb[2]; \
        _Pragma("unroll") for (int s2 = 0; s2 < 2; ++s2) { u32x4 w; w.x = pk_bf16(S[8 * s2 + 0], S[8 * s2 + 1]); w.y = pk_bf16(S[8 * s2 + 2], S[8 * s2 + 3]); w.z = pk_bf16(S[8 * s2 + 4], S[8 * s2 + 5]); w.w = pk_bf16(S[8 * s2 + 6], S[8 * s2 + 7]); pb[s2] = __builtin_bit_cast(bf16x8, w); } \
        _Pragma("unroll") for (int s2 = 0; s2 < 2; ++s2) { _Pragma("unroll") for (int db = 0; db < 2; ++db) { \
                const s16x4 av = vtr(wl + vro + db * 2048 + s2 * 1024), bq = vtr(wl + vro + db * 2048 + s2 * 1024 + 512); \
                bf16x8 vf; vf[0] = av[0]; vf[1] = av[1]; vf[2] = av[2]; vf[3] = av[3]; vf[4] = bq[0]; vf[5] = bq[1]; vf[6] = bq[2]; vf[7] = bq[3]; \
                if (db == 0) O0 = __builtin_amdgcn_mfma_f32_32x32x16_bf16(vf, pb[s2], O0, 0, 0, 0); else O1 = __builtin_amdgcn_mfma_f32_32x32x16_bf16(vf, pb[s2], O1, 0, 0, 0); } } \
    } while (0)
    for (int j0 = jfirst; j0 < 5; j0 += 2) {
        ATT_BLOCK(j0, krA, vrA);
        if (j0 + 1 < 5) ATT_BLOCK(j0 + 1, krB, vrB);
    }
#undef ATT_BLOCK
    const float l_tot = l_run + __shfl_xor(l_run, 32), inv = 1.f / l_tot;
    const int rown = (b << 13) + (((m0 + qi) << sh) | c);
    bf16_t* op = OG + ((size_t)g * NP + rown) * 512 + h * 64 + 4 * hi;
#pragma unroll
    for (int i4 = 0; i4 < 4; ++i4) {
        u32x2 w0, w1;
        w0.x = pk_bf16(O0[4 * i4 + 0] * inv, O0[4 * i4 + 1] * inv); w0.y = pk_bf16(O0[4 * i4 + 2] * inv, O0[4 * i4 + 3] * inv);
        w1.x = pk_bf16(O1[4 * i4 + 0] * inv, O1[4 * i4 + 1] * inv); w1.y = pk_bf16(O1[4 * i4 + 2] * inv, O1[4 * i4 + 3] * inv);
        *(u32x2*)(op + 8 * i4) = w0; *(u32x2*)(op + 32 + 8 * i4) = w1;
    }
    if (hi == 0) LSE[((size_t)g * NP + rown) * 8 + h] = m_run + log2f(l_tot);
}

__device__ __forceinline__ void attn_sample_task(int task, const bf16_t* Qb, const bf16_t* Kb, const bf16_t* Vb,
                                                 const float* c0, const float* c1, const float* c2, float* SO, float* SL, LAS float* pl, int lane) {
    const int g = task >> 8, b = (task >> 3) & 31, h = task & 7, sh = 2 * g, L = 128 << sh;
    const unsigned long long ca = g == 0 ? (unsigned long long)c0 : (g == 1 ? (unsigned long long)c1 : (unsigned long long)c2);
    const float* cache = (const float*)ca;
    const size_t rowq = ((size_t)(g * 8 + h) * RQ + NP + b) * 64;
    const float qv = bf2f(Qb[rowq + lane]);
    const f32x4* k0p = (const f32x4*)(cache + ((size_t)(b * L + (lane << sh)) * 2) * 512 + h * 64);
    const f32x4* k1p = (const f32x4*)(cache + ((size_t)(b * L + ((lane + 64) << sh)) * 2) * 512 + h * 64);
    f32x4 ka[16], kb[16];
#pragma unroll
    for (int d4 = 0; d4 < 16; ++d4) { ka[d4] = k0p[d4]; kb[d4] = k1p[d4]; }
    float s0 = 0.f, s1 = 0.f;
#pragma unroll
    for (int d4 = 0; d4 < 16; ++d4) {
        const float q0 = __int_as_float(__builtin_amdgcn_readlane(__float_as_int(qv), 4 * d4 + 0)), q1 = __int_as_float(__builtin_amdgcn_readlane(__float_as_int(qv), 4 * d4 + 1));
        const float q2 = __int_as_float(__builtin_amdgcn_readlane(__float_as_int(qv), 4 * d4 + 2)), q3 = __int_as_float(__builtin_amdgcn_readlane(__float_as_int(qv), 4 * d4 + 3));
        s0 += ka[d4].x * q0 + ka[d4].y * q1 + ka[d4].z * q2 + ka[d4].w * q3;
        s1 += kb[d4].x * q0 + kb[d4].y * q1 + kb[d4].z * q2 + kb[d4].w * q3;
    }
    const float kn = bf2f(Kb[rowq + lane]);
    float sn = wave_sum(kn * qv);
    s0 *= C2; s1 *= C2; sn *= C2;
    const float mx = fmaxf(wave_max(fmaxf(s0, s1)), sn);
    const float p0 = exp2f(s0 - mx), p1 = exp2f(s1 - mx), pn = exp2f(sn - mx);
    const float l = wave_sum(p0 + p1) + pn;
    asm volatile("" ::: "memory");
    pl[lane] = p0; pl[64 + lane] = p1;
    asm volatile("s_waitcnt lgkmcnt(0)" ::: "memory");
    const int kq = lane >> 4, d4l = lane & 15;
    const f32x4* vp4 = (const f32x4*)(cache + ((size_t)(b * L) * 2 + 1) * 512 + h * 64) + d4l;
    f32x4 vv[32];
#pragma unroll
    for (int i = 0; i < 32; ++i) vv[i] = vp4[(size_t)((4 * i + kq) << sh) * 256];
    f32x4 oa = {0.f, 0.f, 0.f, 0.f};
#pragma unroll
    for (int i = 0; i < 32; ++i) oa += vv[i] * pl[4 * i + kq];
    asm volatile("s_waitcnt lgkmcnt(0)" ::: "memory");
#pragma unroll
    for (int e = 0; e < 4; ++e) { oa[e] += __shfl_xor(oa[e], 16); oa[e] += __shfl_xor(oa[e], 32); }
    if (lane < 16) {
        const u32x2 vn = *(const u32x2*)(Vb + rowq + 4 * lane);
        const float il = 1.f / l;
        f32x4 o; o.x = (oa.x + pn * bf_lo(vn.x)) * il; o.y = (oa.y + pn * bf_hi(vn.x)) * il; o.z = (oa.z + pn * bf_lo(vn.y)) * il; o.w = (oa.w + pn * bf_hi(vn.y)) * il;
        ((f32x4*)(SO + (size_t)task * 64))[lane] = o;
        if (lane == 0) SL[task] = mx + log2f(l);
    }
}

template <int K>
__device__ __forceinline__ void skinny_tile(const bf16_t* A, int lda, const bf16_t* Bt, int n0, LAS float* red, int wave, int lane, float& r0, float& r1) {
    constexpr int KW = K / 8, NS16 = KW / 16;
    const bf16_t* ap = A + (size_t)(lane & 31) * lda + wave * KW + (lane >> 5) * 8;
    const bf16_t* bp = Bt + (size_t)(n0 + (lane & 31)) * K + wave * KW + (lane >> 5) * 8;
    f32x16 acc;
#pragma unroll
    for (int i = 0; i < 16; ++i) acc[i] = 0.f;
    constexpr int UN = NS16 < 8 ? NS16 : 8;
    for (int s0 = 0; s0 < NS16; s0 += UN) {
        bf16x8 av[UN], bv[UN];
#pragma unroll
        for (int u = 0; u < UN; ++u) { av[u] = *(const bf16x8*)(ap + (s0 + u) * 16); bv[u] = *(const bf16x8*)(bp + (s0 + u) * 16); }
#pragma unroll
        for (int u = 0; u < UN; ++u) acc = __builtin_amdgcn_mfma_f32_32x32x16_bf16(av[u], bv[u], acc, 0, 0, 0);
    }
    const int hi = lane >> 5;
#pragma unroll
    for (int i = 0; i < 16; ++i) red[wave * 1024 + crow(i, hi) * 32 + (lane & 31)] = acc[i];
    __syncthreads();
    const int t = threadIdx.x;
    float a0 = 0.f, a1 = 0.f;
#pragma unroll
    for (int w = 0; w < 8; ++w) { a0 += red[w * 1024 + 2 * t]; a1 += red[w * 1024 + 2 * t + 1]; }
    r0 = a0; r1 = a1;
    __syncthreads();
}

__device__ __forceinline__ void conv_prompt_task(int task, const bf16_t* PC, const float* cw, bf16_t* CV, float* out, int lane) {
    const int strip = task >> 1, col = (task & 1) * 512 + lane * 8;
    const int row_base = strip * 16, t0 = row_base & 8191, b = row_base >> 13;
    float w0[8], w1[8], w2[8], u1[8], u2[8];
    { const f32x4 a = *(const f32x4*)(cw + col), bq = *(const f32x4*)(cw + col + 4);
      const f32x4 c = *(const f32x4*)(cw + 1024 + col), d = *(const f32x4*)(cw + 1024 + col + 4);
      const f32x4 e = *(const f32x4*)(cw + 2048 + col), f = *(const f32x4*)(cw + 2048 + col + 4);
#pragma unroll
      for (int j = 0; j < 4; ++j) { w0[j] = a[j]; w0[4 + j] = bq[j]; w1[j] = c[j]; w1[4 + j] = d[j]; w2[j] = e[j]; w2[4 + j] = f[j]; } }
    if (t0 == 0) {
#pragma unroll
        for (int j = 0; j < 8; ++j) { u1[j] = 0.f; u2[j] = 0.f; }
    } else {
        float a[8], bq[8];
        unpack8(*(const u32x4*)(PC + (size_t)(row_base - 2) * PCW + 1024 + col), a); unpack8(*(const u32x4*)(PC + (size_t)(row_base - 2) * PCW + 2048 + col), bq);
#pragma unroll
        for (int j = 0; j < 8; ++j) u2[j] = a[j] * bq[j];
        unpack8(*(const u32x4*)(PC + (size_t)(row_base - 1) * PCW + 1024 + col), a); unpack8(*(const u32x4*)(PC + (size_t)(row_base - 1) * PCW + 2048 + col), bq);
#pragma unroll
        for (int j = 0; j < 8; ++j) u1[j] = a[j] * bq[j];
    }
#pragma unroll 4
    for (int r = 0; r < 16; ++r) {
        const size_t row = (size_t)(row_base + r);
        float cc[8], ch[8], cb[8], o[8];
        unpack8(*(const u32x4*)(PC + row * PCW + 1024 + col), cc); unpack8(*(const u32x4*)(PC + row * PCW + 2048 + col), ch); unpack8(*(const u32x4*)(PC + row * PCW + col), cb);
#pragma unroll
        for (int j = 0; j < 8; ++j) { const float u = cc[j] * ch[j]; o[j] = cb[j] * (w0[j] * u2[j] + w1[j] * u1[j] + w2[j] * u); u2[j] = u1[j]; u1[j] = u; }
        *(u32x4*)(CV + row * DM + col) = pack8(o);
        if (t0 + r >= 8190) {
            float* op = out + O_CONVP + (size_t)(b * 2 + (t0 + r - 8190)) * 1024 + col;
            f32x4 x0, x1;
#pragma unroll
            for (int j = 0; j < 4; ++j) { x0[j] = u1[j]; x1[j] = u1[4 + j]; }
            *(f32x4*)op = x0; *(f32x4*)(op + 4) = x1;
        }
    }
}

__device__ __forceinline__ void norm1_row(const float* xrow, const bf16_t* mrow, float ss, const float* gpost, const float* gpre, bf16_t* x1row, bf16_t* h2row, int lane) {
    const float rs1 = rsqrtf(ss * (1.f / DM) + EPS);
    f32x4 v[4]; float s = 0.f;
#pragma unroll
    for (int j = 0; j < 4; ++j) {
        const f32x4 xv = ((const f32x4*)xrow)[lane + 64 * j], gp = ((const f32x4*)gpost)[lane + 64 * j];
        const u32x2 mw = ((const u32x2*)mrow)[lane + 64 * j];
        v[j].x = xv.x + bf_lo(mw.x) * rs1 * gp.x; v[j].y = xv.y + bf_hi(mw.x) * rs1 * gp.y; v[j].z = xv.z + bf_lo(mw.y) * rs1 * gp.z; v[j].w = xv.w + bf_hi(mw.y) * rs1 * gp.w;
        s += (v[j].x * v[j].x + v[j].y * v[j].y) + (v[j].z * v[j].z + v[j].w * v[j].w);
    }
    const float rs2 = rsqrtf(wave_sum(s) * (1.f / DM) + EPS);
#pragma unroll
    for (int j = 0; j < 4; ++j) {
        const f32x4 gg = ((const f32x4*)gpre)[lane + 64 * j];
        { u32x2 xo; xo.x = pk_bf16(v[j].x, v[j].y); xo.y = pk_bf16(v[j].z, v[j].w); ((u32x2*)x1row)[lane + 64 * j] = xo; }
        u32x2 o; o.x = pk_bf16(v[j].x * rs2 * gg.x, v[j].y * rs2 * gg.y); o.y = pk_bf16(v[j].z * rs2 * gg.z, v[j].w * rs2 * gg.w);
        ((u32x2*)h2row)[lane + 64 * j] = o;
    }
}
__device__ __forceinline__ void norm2_row(float* yrow, const bf16_t* x1row, const bf16_t* frow, float ss, const float* gpost, int lane) {
    const float rs = rsqrtf(ss * (1.f / DM) + EPS);
#pragma unroll
    for (int j = 0; j < 4; ++j) {
        const u32x2 xw = ((const u32x2*)x1row)[lane + 64 * j]; const f32x4 gp = ((const f32x4*)gpost)[lane + 64 * j];
        const u32x2 mw = ((const u32x2*)frow)[lane + 64 * j];
        f32x4 xv;
        xv.x = bf_lo(xw.x) + bf_lo(mw.x) * rs * gp.x; xv.y = bf_hi(xw.x) + bf_hi(mw.x) * rs * gp.y; xv.z = bf_lo(xw.y) + bf_lo(mw.y) * rs * gp.z; xv.w = bf_hi(xw.y) + bf_hi(mw.y) * rs * gp.w;
        ((f32x4*)yrow)[lane + 64 * j] = xv;
    }
}

#define WIN ((bf16_t*)(ws + WS_WIN))
#define WAO ((bf16_t*)(ws + WS_WAO))
#define WCO ((bf16_t*)(ws + WS_WCO))
#define WO ((bf16_t*)(ws + WS_WO))
#define WF1 ((bf16_t*)(ws + WS_WF1))
#define WF2 ((bf16_t*)(ws + WS_WF2))
#define H ((bf16_t*)(ws + WS_H))
#define Qb ((bf16_t*)(ws + WS_Q))
#define Kb ((bf16_t*)(ws + WS_K))
#define Vb ((bf16_t*)(ws + WS_V))
#define HID ((bf16_t*)(ws + WS_HID))
#define PC ((bf16_t*)(ws + WS_PC))
#define OG ((bf16_t*)(ws + WS_OG))
#define LSE ((float*)(ws + WS_LSE))
#define ATTN ((bf16_t*)(ws + WS_ATTN))
#define CV ((bf16_t*)(ws + WS_CV))
#define T ((bf16_t*)(ws + WS_T))
#define X1 ((bf16_t*)(ws + WS_T))
#define MIXIN ((bf16_t*)(ws + WS_MIXIN))
#define MIX ((bf16_t*)(ws + WS_MIX))
#define H2 ((bf16_t*)(ws + WS_H2))
#define Fb ((bf16_t*)(ws + WS_F))
#define SS ((float*)(ws + WS_SS))
#ifndef REP_P1
#define REP_P1 1
#endif
#ifndef REP_SYNC
#define REP_SYNC 1
#endif
#ifndef REP_P0
#define REP_P0 1
#endif
#ifndef REP_P2
#define REP_P2 1
#endif
constexpr int CPY_N = 16;
constexpr size_t CPY_T0 = (size_t)32 * 128 * 256, CPY_T1 = CPY_T0 + (size_t)32 * 512 * 256, CPY_TOT = CPY_T1 + (size_t)32 * 2048 * 256;
struct CopyOrder : pg8::StaticOrder {
    const f32x4 *s0, *s1, *s2; f32x4 *d0, *d1, *d2;
    mutable int ui;
    __device__ __forceinline__ void done(const pg8::Unit&) const {
        const size_t base = ((size_t)ui * G + c) * (size_t)(CPY_N * NTHREADS) + threadIdx.x; ++ui;
        f32x4 v[CPY_N];
#pragma unroll
        for (int j = 0; j < CPY_N; ++j) {
            const size_t f = base + (size_t)j * NTHREADS;
            if (f < CPY_T0) { if ((f & (128 * 256 - 1)) < 127 * 256) v[j] = __builtin_nontemporal_load(s0 + f + 256); }
            else if (f < CPY_T1) { const size_t r = f - CPY_T0; if ((r & (512 * 256 - 1)) < 511 * 256) v[j] = __builtin_nontemporal_load(s1 + r + 256); }
            else if (f < CPY_TOT) { const size_t r = f - CPY_T1; if ((r & (2048 * 256 - 1)) < 2047 * 256) v[j] = __builtin_nontemporal_load(s2 + r + 256); }
        }
#pragma unroll
        for (int j = 0; j < CPY_N; ++j) {
            const size_t f = base + (size_t)j * NTHREADS;
            if (f < CPY_T0) { if ((f & (128 * 256 - 1)) < 127 * 256) __builtin_nontemporal_store(v[j], d0 + f); }
            else if (f < CPY_T1) { const size_t r = f - CPY_T0; if ((r & (512 * 256 - 1)) < 511 * 256) __builtin_nontemporal_store(v[j], d1 + r); }
            else if (f < CPY_TOT) { const size_t r = f - CPY_T1; if ((r & (2048 * 256 - 1)) < 2047 * 256) __builtin_nontemporal_store(v[j], d2 + r); }
        }
        asm volatile("s_waitcnt vmcnt(0)" ::: "memory");
    }
};
constexpr size_t CPY_HOOK = (size_t)CPY_N * NTHREADS * ((NP / 256) * (INW / 256));
static_assert(CPY_HOOK >= CPY_T1 && CPY_HOOK <= CPY_TOT, "the tail lies in the third cache");

#define XB_TMO      128
#define XB_XCNT(j)  (256  + 64 * (j))
#define XB_XSUB(j)  (1280 + 64 * (j))
#define XB_XGEN(j)  (2304 + 64 * (j))
#define XB_TOP      3328
#define XB_TOPGEN   3392
#define XCD_BAR_WORDS 3456
#define XB_SPIN_CAP (1u << 18)

__device__ __forceinline__ unsigned xb_ld(unsigned* p)              { return __hip_atomic_load(p, __ATOMIC_RELAXED, __HIP_MEMORY_SCOPE_AGENT); }
__device__ __forceinline__ unsigned xb_add(unsigned* p, unsigned v) { return __hip_atomic_fetch_add(p, v, __ATOMIC_RELAXED, __HIP_MEMORY_SCOPE_AGENT); }
__device__ __forceinline__ unsigned xb_xcc_id() { return (unsigned)__builtin_amdgcn_s_getreg((3 << 11) | 20) & 0xFu; }
#define XB_SPIN(cond, bar) do { unsigned _sp = 0; while (cond) { __builtin_amdgcn_s_sleep(1); \
    if ((++_sp & 255u) == 0u) { if (xb_ld(&(bar)[XB_TMO])) break; if (_sp > XB_SPIN_CAP) { atomicAdd(&(bar)[XB_TMO], 1u); break; } } } } while (0)

struct XcdBarrier {
    unsigned* bar; unsigned x;
    volatile LAS unsigned* st;
};

__device__ __forceinline__ XcdBarrier xcd_barrier_post(unsigned* bar, volatile LAS unsigned* st) {
    XcdBarrier b; b.bar = bar; b.x = xb_xcc_id(); b.st = st;
    if (threadIdx.x == 0) (void)xb_add(&bar[XB_XCNT(b.x)], 1u);
    return b;
}
__device__ __forceinline__ void xcd_barrier_complete(unsigned* bar, unsigned x, unsigned& nloc, unsigned& nx) {
    const unsigned G = gridDim.x * gridDim.y * gridDim.z;
    unsigned sum, cnt, mine, sp = 0u;
    for (;;) {
        sum = 0u; cnt = 0u; mine = 0u;
#pragma unroll
        for (unsigned j = 0; j < 16; ++j) { const unsigned c = xb_ld(&bar[XB_XCNT(j)]); sum += c; cnt += (c > 0u) ? 1u : 0u; mine = (j == x) ? c : mine; }
        if (sum == G) break;
        __builtin_amdgcn_s_sleep(1);
        if ((++sp & 255u) == 0u) { if (xb_ld(&bar[XB_TMO])) break; if (sp > XB_SPIN_CAP) { atomicAdd(&bar[XB_TMO], 1u); break; } }
    }
    nloc = mine > 0u ? mine : 1u; nx = cnt > 0u ? cnt : 1u;
}

__device__ __forceinline__ void xcd_barrier(const XcdBarrier& b) {
    asm volatile("s_waitcnt vmcnt(0)" ::: "memory");
    __syncthreads();
    if (threadIdx.x == 0) {
        unsigned* bar = b.bar;
        __builtin_amdgcn_s_waitcnt(0);
        unsigned nloc = b.st[0], nx = b.st[1];
        if (nloc == 0u) { xcd_barrier_complete(bar, b.x, nloc, nx); b.st[0] = nloc; b.st[1] = nx; }
        const unsigned old = xb_add(&bar[XB_XSUB(b.x)], 1u);
        const unsigned gen = old / nloc;
        if (old + 1u == (gen + 1u) * nloc) {
            __builtin_amdgcn_fence(__ATOMIC_RELEASE, "agent");
            asm volatile("s_waitcnt vmcnt(0)" ::: "memory");
            const unsigned og = xb_add(&bar[XB_TOP], 1u);
            const unsigned tg = og / nx;
            if (og + 1u == (tg + 1u) * nx) xb_add(&bar[XB_TOPGEN], 1u);
            else XB_SPIN(xb_ld(&bar[XB_TOPGEN]) == tg, bar);
            __builtin_amdgcn_fence(__ATOMIC_ACQUIRE, "agent");
            xb_add(&bar[XB_XGEN(b.x)], 1u);
            asm volatile("s_waitcnt vmcnt(0)" ::: "memory");
        } else {
            XB_SPIN(xb_ld(&bar[XB_XGEN(b.x)]) == gen, bar);
            __builtin_amdgcn_fence(__ATOMIC_ACQUIRE, "agent");
            asm volatile("s_waitcnt vmcnt(0)" ::: "memory");
        }
    }
    __syncthreads();
}

struct Args { const float* in[17]; float* out; unsigned char* ws; };

__global__ void __launch_bounds__(NTHREADS, 2) fwd_kernel(Args a) {
    extern __shared__ __attribute__((aligned(16))) unsigned char lds_raw[];
    cg::grid_group grid = cg::this_grid();
    LAS unsigned char* lds = (LAS unsigned char*)lds_raw;
    const int tid = threadIdx.x, lane = tid & 63, wave = __builtin_amdgcn_readfirstlane(tid >> 6);
    const int G = gridDim.x, gw = blockIdx.x * 8 + wave, NGW = G * 8;
    const size_t gtid = (size_t)blockIdx.x * NTHREADS + tid, gthreads = (size_t)G * NTHREADS;
    unsigned char* ws = a.ws; float* out = a.out;
    volatile LAS unsigned* bst = (volatile LAS unsigned*)(lds + 131072);
    if (tid == 0) { bst[0] = 0u; bst[1] = 0u; }
    __syncthreads();
    XcdBarrier xbar = xcd_barrier_post((unsigned*)(ws + WS_BAR), bst);
    if (a.ws == nullptr) grid.sync();
    {
        LAS float* scr = (LAS float*)(lds + wave * 8448);
        constexpr int I_IN = (DM / 64) * (INW / 32);
        for (int it = gw; it < I_IN; it += NGW) transpose_item(a.in[6], DM, INW, WIN, scr, it, lane);
        for (int m = gw; m < NP + NS; m += NGW) {
            const float* xr = m < NP ? a.in[0] + (size_t)m * DM : a.in[1] + (size_t)(m - NP) * DM;
            rms_row_bf16(xr, a.in[13], H + (size_t)m * DM, lane);
        }
        for (size_t i = gtid; i < (size_t)2 * MPAD; i += gthreads) SS[i] = 0.f;
    }
    xcd_barrier(xbar);

    {
        const int sb = ((int)blockIdx.x + G - (G >> 1)) % G;
        for (int tile = sb; tile < INW / 32; tile += (G >> 1)) {
            if (sb >= (G >> 1)) break;
            float r0, r1; skinny_tile<DM>(H + (size_t)NP * DM, DM, WIN, tile * 32, (LAS float*)lds, wave, lane, r0, r1);
            const int b = tid >> 4, col = tile * 32 + 2 * (tid & 15);
            if (col < 4608) {
                const int which = col / 1536, cin = col - which * 1536, g = cin >> 9, h = (cin >> 6) & 7, d = cin & 63;
                *(unsigned*)(Qb + (size_t)which * (QKV_SZ / 2) + ((size_t)(g * 8 + h) * RQ + NP + b) * 64 + d) = pk_bf16(r0, r1);
                if (which) {
                    const int L = 128 << (2 * g); const size_t ob = g == 0 ? O_KV128S : (g == 1 ? O_KV512S : O_KV2048S);
                    float* o = out + ob + (((size_t)b * L + (L - 1)) * 2 + (which - 1)) * 512 + h * 64 + d;
                    o[0] = r0; o[1] = r1;
                }
            } else {
                *(unsigned*)(PC + (size_t)(NP + b) * PCW + (col - 4608)) = pk_bf16(r0, r1);
            }
        }
        pg8::Gemm g{H, WIN, NP, INW, DM}; CopyOrder S; S.init(NP, INW, G, (int)blockIdx.x);
        S.s0 = (const f32x4*)a.in[2]; S.s1 = (const f32x4*)a.in[3]; S.s2 = (const f32x4*)a.in[4];
        S.d0 = (f32x4*)(out + O_KV128S); S.d1 = (f32x4*)(out + O_KV512S); S.d2 = (f32x4*)(out + O_KV2048S); S.ui = 0;
        EpiIn E{Qb, PC};
        pg8::gemm_phase<EpiIn, CopyOrder, true, true>(lds, g, S, E);
        if ((int)blockIdx.x >= (G >> 1)) {
            const int tid = threadIdx.x, lane = tid & 63, wave = __builtin_amdgcn_readfirstlane(tid >> 6);
            LAS float* scr = (LAS float*)(lds + wave * 8448);
            constexpr int I_AO = (512 / 64) * (DM / 32), I_CO = (DM / 64) * (DM / 32), I_O = I_CO, I_F1 = (DM / 64) * (DFF / 32), I_F2 = (DFF / 64) * (DM / 32);
            constexpr int NIT = I_AO + I_CO + I_O + I_F1 + I_F2;
            const int hw = ((int)blockIdx.x - (G >> 1)) * 8 + wave, HW = (G - (G >> 1)) * 8;
            for (int it = hw; it < NIT; it += HW) {
                int r = it;
                if (r < I_AO) { transpose_item(a.in[8], 512, DM, WAO, scr, r, lane); continue; } r -= I_AO;
                if (r < I_CO) { transpose_item(a.in[9], DM, DM, WCO, scr, r, lane); continue; } r -= I_CO;
                if (r < I_O) { transpose_item(a.in[10], DM, DM, WO, scr, r, lane); continue; } r -= I_O;
                if (r < I_F1) { transpose_item(a.in[11], DM, DFF, WF1, scr, r, lane); continue; } r -= I_F1;
                transpose_item(a.in[12], DFF, DM, WF2, scr, r, lane);
            }
            const size_t ht = (size_t)((int)blockIdx.x - (G >> 1)) * NTHREADS + tid, HT = (size_t)(G - (G >> 1)) * NTHREADS;
            const f32x4* s2 = (const f32x4*)a.in[4]; f32x4* d2 = (f32x4*)(out + O_KV2048S);
#pragma unroll 4
            for (size_t f = CPY_HOOK + ht; f < CPY_TOT; f += HT) {
                const size_t r = f - CPY_T1;
                if ((r & (2048 * 256 - 1)) < 2047 * 256) { const f32x4 v = __builtin_nontemporal_load(s2 + r + 256); __builtin_nontemporal_store(v, d2 + r); }
            }
        }
    }
    xcd_barrier(xbar);

    {
        LAS unsigned char* wl = lds + wave * 8704;
        for (int t = gw; t < 3 * 8 * 512; t += NGW) attn_prompt_task(t, Qb, Kb, Vb, OG, LSE, wl, lane);
#if REP_P2 == 2
        for (int t = gw; t < 3 * 8 * 512; t += NGW) attn_prompt_task(t, Qb, Kb, Vb, OG, LSE, wl, lane);
#endif
        for (int t = NGW - 1 - gw; t < 768; t += NGW) attn_sample_task(t, Qb, Kb, Vb, a.in[2], a.in[3], a.in[4], (float*)(ws + WS_SO), (float*)(ws + WS_SO) + 768 * 64, (LAS float*)wl, lane);
        for (int t = gw; t < 2048; t += NGW) conv_prompt_task(t, PC, a.in[7], CV, out, lane);
        for (size_t i = gtid; i < 32 * 128; i += gthreads) {
            const int b = (int)(i >> 7), col = (int)(i & 127) * 8; const size_t row = (size_t)(NP + b);
            float cc[8], ch[8], cb[8], o[8];
            unpack8(*(const u32x4*)(PC + row * PCW + 1024 + col), cc); unpack8(*(const u32x4*)(PC + row * PCW + 2048 + col), ch); unpack8(*(const u32x4*)(PC + row * PCW + col), cb);
            const float* st = a.in[5] + (size_t)b * 2048 + col; const float* cw = a.in[7] + col;
            float* oc = out + O_CONVS + (size_t)b * 2048 + col;
#pragma unroll
            for (int j = 0; j < 8; ++j) {
                const float u = cc[j] * ch[j], s0 = st[j], s1 = st[1024 + j];
                o[j] = cb[j] * (cw[j] * s0 + cw[1024 + j] * s1 + cw[2048 + j] * u);
                oc[j] = s1; oc[1024 + j] = u;
            }
            *(u32x4*)(CV + row * DM + col) = pack8(o);
        }
#pragma unroll
        for (int g = 0; g < 3; ++g) {
            const int sh = 2 * g, W = 128 << sh; float* dst = out + (g == 0 ? O_KV128P : (g == 1 ? O_KV512P : O_KV2048P));
            for (size_t i = gtid; i < (size_t)256 * W; i += gthreads) {
                const int d8 = (int)(i & 7), h = (int)(i >> 3) & 7, kv = (int)(i >> 6) & 1; const int br = (int)(i >> 7), r = br & (W - 1), b = br >> (7 + sh);
                const int t = 8192 - W + r, rowp = (b << 13) | ((t & ((1 << sh) - 1)) << (13 - sh)) | (t >> sh);
                float f[8]; unpack8(*(const u32x4*)((kv ? Vb : Kb) + ((size_t)(g * 8 + h) * RQ + rowp) * 64 + d8 * 8), f);
                float* o = dst + i * 8;
                *(f32x4*)o = (f32x4){f[0], f[1], f[2], f[3]}; *(f32x4*)(o + 4) = (f32x4){f[4], f[5], f[6], f[7]};
            }
        }
    }
    xcd_barrier(xbar);

    for (size_t i = gtid; i < (size_t)NP * 64; i += gthreads) {
        const size_t row = i >> 6; const int hd = (int)(i & 63), h = hd >> 3;
        const float L0 = LSE[row * 8 + h], L1 = LSE[((size_t)NP + row) * 8 + h], L2 = LSE[((size_t)2 * NP + row) * 8 + h];
        const float M = fmaxf(fmaxf(L0, L1), L2);
        float w0 = exp2f(L0 - M), w1 = exp2f(L1 - M), w2 = exp2f(L2 - M); const float inv = 1.f / (w0 + w1 + w2); w0 *= inv; w1 *= inv; w2 *= inv;
        float x0[8], x1[8], x2[8], o[8];
        unpack8(*(const u32x4*)(OG + row * 512 + hd * 8), x0); unpack8(*(const u32x4*)(OG + ((size_t)NP + row) * 512 + hd * 8), x1); unpack8(*(const u32x4*)(OG + ((size_t)2 * NP + row) * 512 + hd * 8), x2);
#pragma unroll
        for (int j = 0; j < 8; ++j) o[j] = w0 * x0[j] + w1 * x1[j] + w2 * x2[j];
        *(u32x4*)(ATTN + row * 512 + hd * 8) = pack8(o);
    }
    {
        const float* SO = (const float*)(ws + WS_SO); const float* SL = SO + 768 * 64;
        for (size_t i = gtid; i < (size_t)NS * 8 * 64; i += gthreads) {
            const int bh = (int)(i >> 6), d = (int)(i & 63);
            const float L0 = SL[bh], L1 = SL[256 + bh], L2 = SL[512 + bh];
            const float M = fmaxf(fmaxf(L0, L1), L2);
            const float w0 = exp2f(L0 - M), w1 = exp2f(L1 - M), w2 = exp2f(L2 - M);
            const float o = (w0 * SO[(size_t)bh * 64 + d] + w1 * SO[(size_t)(256 + bh) * 64 + d] + w2 * SO[(size_t)(512 + bh) * 64 + d]) / (w0 + w1 + w2);
            ATTN[(size_t)(NP + (bh >> 3)) * 512 + (bh & 7) * 64 + d] = (bf16_t)(pk_bf16(o, 0.f) & 0xffffu);
        }
    }
    xcd_barrier(xbar);

    {
        if ((int)blockIdx.x < DM / 32) {
            const int n0 = (int)blockIdx.x * 32; float a0, a1, c0, c1;
            skinny_tile<512>(ATTN + (size_t)NP * 512, 512, WAO, n0, (LAS float*)lds, wave, lane, a0, a1);
            skinny_tile<DM>(CV + (size_t)NP * DM, DM, WCO, n0, (LAS float*)lds, wave, lane, c0, c1);
            const int b = tid >> 4, col = n0 + 2 * (tid & 15);
            const unsigned ga = *(const unsigned*)(PC + (size_t)(NP + b) * PCW + 3072 + col), gc = *(const unsigned*)(PC + (size_t)(NP + b) * PCW + 4096 + col);
            *(unsigned*)(MIXIN + (size_t)(NP + b) * DM + col) = pk_bf16(sigm(bf_lo(ga)) * a0 + sigm(bf_lo(gc)) * c0, sigm(bf_hi(ga)) * a1 + sigm(bf_hi(gc)) * c1);
        }
        pg8::StaticOrder S; S.init(NP, DM, G, (int)blockIdx.x);
        { pg8::Gemm g{ATTN, WAO, NP, DM, 512}; EpiGateA E{PC, T}; pg8::gemm_phase<EpiGateA, pg8::StaticOrder, true, true>(lds, g, S, E); }
        { pg8::Gemm g{CV, WCO, NP, DM, DM}; EpiGateC E{PC, T, MIXIN}; pg8::gemm_phase<EpiGateC, pg8::StaticOrder, true, true>(lds, g, S, E); }
    }
    xcd_barrier(xbar);

    {
        if ((int)blockIdx.x < DM / 32) {
            const int n0 = (int)blockIdx.x * 32; float r0, r1;
            skinny_tile<DM>(MIXIN + (size_t)NP * DM, DM, WO, n0, (LAS float*)lds, wave, lane, r0, r1);
            const int b = tid >> 4, col = n0 + 2 * (tid & 15);
            *(unsigned*)(MIX + (size_t)(NP + b) * DM + col) = pk_bf16(r0, r1);
            float sq = r0 * r0 + r1 * r1; sq += __shfl_xor(sq, 1); sq += __shfl_xor(sq, 2); sq += __shfl_xor(sq, 4); sq += __shfl_xor(sq, 8);
            if ((tid & 15) == 0) atomicAdd(SS + NP + b, sq);
        }
        pg8::Gemm g{MIXIN, WO, NP, DM, DM}; pg8::StaticOrder S; S.init(NP, DM, G, (int)blockIdx.x);
        EpiSS E{MIX, SS};
        pg8::gemm_phase<EpiSS, pg8::StaticOrder, true, true>(lds, g, S, E);
    }
    xcd_barrier(xbar);

    for (int m = gw; m < NP + NS; m += NGW) {
        const float* xr = m < NP ? a.in[0] + (size_t)m * DM : a.in[1] + (size_t)(m - NP) * DM;
        norm1_row(xr, MIX + (size_t)m * DM, SS[m], a.in[14], a.in[15], X1 + (size_t)m * DM, H2 + (size_t)m * DM, lane);
    }
    xcd_barrier(xbar);

    {
        if ((int)blockIdx.x < DFF / 32) {
            const int n0 = (int)blockIdx.x * 32; float r0, r1;
            skinny_tile<DM>(H2 + (size_t)NP * DM, DM, WF1, n0, (LAS float*)lds, wave, lane, r0, r1);
            const int b = tid >> 4, col = n0 + 2 * (tid & 15);
            r0 = fmaxf(r0, 0.f); r1 = fmaxf(r1, 0.f);
            *(unsigned*)(HID + (size_t)(NP + b) * DFF + col) = pk_bf16(r0 * r0, r1 * r1);
        }
        pg8::Gemm g{H2, WF1, NP, DFF, DM}; pg8::StaticOrder S; S.init(NP, DFF, G, (int)blockIdx.x);
        EpiRelu2 E{HID};
        pg8::gemm_phase<EpiRelu2, pg8::StaticOrder, true, true>(lds, g, S, E);
    }
    xcd_barrier(xbar);

    {
        if ((int)blockIdx.x < DM / 32) {
            const int n0 = (int)blockIdx.x * 32; float r0, r1;
            skinny_tile<DFF>(HID + (size_t)NP * DFF, DFF, WF2, n0, (LAS float*)lds, wave, lane, r0, r1);
            const int b = tid >> 4, col = n0 + 2 * (tid & 15);
            *(unsigned*)(Fb + (size_t)(NP + b) * DM + col) = pk_bf16(r0, r1);
            float sq = r0 * r0 + r1 * r1; sq += __shfl_xor(sq, 1); sq += __shfl_xor(sq, 2); sq += __shfl_xor(sq, 4); sq += __shfl_xor(sq, 8);
            if ((tid & 15) == 0) atomicAdd(SS + MPAD + NP + b, sq);
        }
        pg8::Gemm g{HID, WF2, NP, DM, DFF}; pg8::StaticOrder S; S.init(NP, DM, G, (int)blockIdx.x);
        EpiSS E{Fb, SS + MPAD};
        pg8::gemm_phase<EpiSS, pg8::StaticOrder, true, true>(lds, g, S, E);
    }
    xcd_barrier(xbar);

    for (int m = gw; m < NP + NS; m += NGW) {
        float* yr = m < NP ? out + O_YP + (size_t)m * DM : out + O_YS + (size_t)(m - NP) * DM;
        norm2_row(yr, X1 + (size_t)m * DM, Fb + (size_t)m * DM, SS[MPAD + m], a.in[16], lane);
    }
}

extern "C" void kernel_launch(void* const* d_in, const int* in_sizes, int n_in, void* d_out, int out_size, void* d_ws, size_t ws_size, hipStream_t stream) {
    static int grid_blocks = 0;
    if (grid_blocks == 0) {
        if (n_in != 17 || ws_size < WS_END) { fprintf(stderr, "kernel_launch: unexpected n_in %d or ws_size %zu (< %zu)\n", n_in, ws_size, (size_t)WS_END); grid_blocks = -1; return; }
        int dev = 0, cus = 0, per_cu = 0;
        hipGetDevice(&dev);
        hipDeviceGetAttribute(&cus, hipDeviceAttributeMultiprocessorCount, dev);
        if (hipFuncSetAttribute((const void*)fwd_kernel, hipFuncAttributeMaxDynamicSharedMemorySize, LDS_BYTES) != hipSuccess) { fprintf(stderr, "kernel_launch: hipFuncSetAttribute failed\n"); grid_blocks = -1; return; }
        if (hipOccupancyMaxActiveBlocksPerMultiprocessor(&per_cu, (const void*)fwd_kernel, NTHREADS, LDS_BYTES) != hipSuccess || per_cu < 1) { fprintf(stderr, "kernel_launch: occupancy query failed (%d)\n", per_cu); per_cu = 1; (void)hipGetLastError(); }
        if (per_cu > 1) per_cu = 1;
        grid_blocks = cus * per_cu;
    }
    if (grid_blocks < 0) return;
    if (hipMemsetAsync((char*)d_ws + WS_BAR, 0, 16384, stream) != hipSuccess) { fprintf(stderr, "kernel_launch: memset failed\n"); return; }
    Args a{};
    for (int i = 0; i < 17; ++i) a.in[i] = (const float*)d_in[i];
    a.out = (float*)d_out; a.ws = (unsigned char*)d_ws;
    void* args[] = {&a};
    hipError_t e = hipLaunchCooperativeKernel((const void*)fwd_kernel, dim3(grid_blocks), dim3(NTHREADS), args, LDS_BYTES, stream);
    if (e != hipSuccess) fprintf(stderr, "cooperative launch failed: %s (grid %d)\n", hipGetErrorString(e), grid_blocks);
}
```

```cpp
#include <hip/hip_runtime.h>
#include <hip/hip_cooperative_groups.h>
#include <cstdio>
#include <cstdint>
namespace cg = cooperative_groups;
namespace pg8 {
#define PG8_LAS __attribute__((address_space(3)))
typedef unsigned short bf16_t;
typedef short bf16x8 __attribute__((ext_vector_type(8)));
typedef float f32x4 __attribute__((ext_vector_type(4)));
typedef unsigned u32x4 __attribute__((ext_vector_type(4)));
constexpr int BM = 256, BK = 64, HALF = 128, HTB = HALF * BK * 2  , STAGE_BYTES = 8 * HTB, NXCD = 8, WGM = 8;

__host__ __device__ __forceinline__ int lds_byte(int r, int c) { const int st = (r >> 4) * 2 + (c >> 5), rr = r & 15, cc = c & 31, ob = rr * 64 + cc * 2; return st * 1024 + (ob ^ (((ob >> 9) & 1) << 5)); }
__host__ __device__ __forceinline__ void stage_rc(int b, int& R, int& C) { const int st = b / 1024, sb = b % 1024, swz = sb ^ (((sb >> 9) & 1) << 5); R = (st >> 1) * 16 + swz / 64; C = (st & 1) * 32 + (swz % 64) / 2; }
__host__ __device__ __forceinline__ int perm32(int rho) { const int n = rho >> 4, i = rho & 15; return 8 * (i >> 2) + 4 * n + (i & 3); }

struct Unit { int pm, pn; };
struct Gemm { const bf16_t* A; const bf16_t* Bt; int M, N, K; };

struct StaticOrder {
    int nM, nN, nwg, G, c;
    __host__ __device__ void init(int M, int N, int G_, int c_) { nM = M / BM; nN = N / BM; nwg = nM * nN; G = G_; c = c_; }
    __host__ __device__ bool next(int i, Unit& u) const {
        const long L = (long)i * G + c; if (L >= nwg) return false;
        int wgid = (int)L; { const int q = nwg / NXCD, r = nwg % NXCD, xcd = wgid % NXCD, off = wgid / NXCD; wgid = (xcd < r ? xcd * (q + 1) : r * (q + 1) + (xcd - r) * q) + off; }
        const int nig = WGM * nN, gid = wgid / nig, fm = gid * WGM, gsz = (nM - fm) < WGM ? (nM - fm) : WGM;
        u.pm = fm + ((wgid % nig) % gsz); u.pn = (wgid % nig) / gsz; return true;
    }
    __device__ __forceinline__ void a_ready(const Unit&) const {}
    __device__ __forceinline__ void done(const Unit&) const {}
};
__device__ __forceinline__ unsigned cvt_pk_bf16(float lo, float hi) { unsigned r; asm volatile("v_cvt_pk_bf16_f32 %0, %1, %2" : "=v"(r) : "v"(lo), "v"(hi)); return r; }
template <class Epi, class Sched, bool ALIGN_EPI = false, bool SP2 = false>
__device__ __forceinline__ void gemm_phase(PG8_LAS unsigned char* lds, const Gemm g, const Sched& S, const Epi& E) {
    int tid_ = threadIdx.x; asm volatile("" : "+v"(tid_));
    const int tid = tid_, wid = __builtin_amdgcn_readfirstlane(tid >> 6), lane = tid & 63, wr = wid >> 2, wc = wid & 3, fr = lane & 15, fq = lane >> 4;
    const int K = g.K, nt = K / BK;
    unsigned voffA[2], voffB[2];
#pragma unroll
    for (int i = 0; i < 2; ++i) { int R, C; stage_rc(tid * 16 + i * 8192, R, C); const int Rb = Epi::PERM ? ((R & ~31) + perm32(R & 31)) : R;
        voffA[i] = (unsigned)(R * K + C) * 2u; voffB[i] = (unsigned)(Rb * K + C) * 2u; }
    const size_t kstep = (size_t)(BK * 2);
    const size_t hstep = (size_t)HALF * K * 2;
    const size_t tstep = 2 * hstep;
    const unsigned ldsw = (unsigned)wid * 1024u;
    const int aoff = lds_byte(wr * 64 + fr, fq * 8), boff = lds_byte(wc * 32 + fr, fq * 8);
#define PG8_SA(b, h) (((b) * 2 + (h)) * HTB)
#define PG8_SB(b, h) ((4 + (b) * 2 + (h)) * HTB)
#define PG8_STAGE(bufoff, gbase, voff) do { _Pragma("unroll") for (int _i = 0; _i < 2; ++_i) \
        __builtin_amdgcn_global_load_lds((const unsigned*)((const char*)(gbase) + (voff)[_i]), (PG8_LAS unsigned*)(lds + (bufoff) + ldsw + _i * 8192), 16, 0, 0); } while (0)
#define PG8_LDA(dst, b, h) do { _Pragma("unroll") for (int m = 0; m < 4; ++m) _Pragma("unroll") for (int k = 0; k < 2; ++k) dst[m][k] = *(const PG8_LAS bf16x8*)(lds + PG8_SA(b, h) + aoff + m * 2048 + k * 1024); } while (0)
#define PG8_LDB(dst, b, h) do { _Pragma("unroll") for (int n = 0; n < 2; ++n) _Pragma("unroll") for (int k = 0; k < 2; ++k) dst[n][k] = *(const PG8_LAS bf16x8*)(lds + PG8_SB(b, h) + boff + n * 2048 + k * 1024); } while (0)
#define PG8_MMA(ai, bj, At, Bt) do { __builtin_amdgcn_s_setprio(1); _Pragma("unroll") for (int m = 0; m < 4; ++m) _Pragma("unroll") for (int n = 0; n < 2; ++n) _Pragma("unroll") for (int k = 0; k < 2; ++k) \
        acc[ai][bj][m][n] = __builtin_amdgcn_mfma_f32_16x16x32_bf16(Bt[n][k], At[m][k], acc[ai][bj][m][n], 0, 0, 0); __builtin_amdgcn_s_setprio(0); } while (0)
#define PG8_WAIT_V(n) asm volatile("s_waitcnt vmcnt(" #n ")" ::: "memory")
#define PG8_WAIT_L(n) asm volatile("s_waitcnt lgkmcnt(" #n ")" ::: "memory")
#define PG8_BAR __builtin_amdgcn_s_barrier()
#define PG8_SCHED __builtin_amdgcn_sched_barrier(0)
    Unit cur, nxt; int ui = 0;
    if (!S.next(0, cur)) return;
    f32x4 acc[2][2][4][2];
#pragma unroll
    for (int a = 0; a < 2; ++a)
#pragma unroll
        for (int b = 0; b < 2; ++b)
#pragma unroll
            for (int m = 0; m < 4; ++m)
#pragma unroll
                for (int n = 0; n < 2; ++n) acc[a][b][m][n] = (f32x4){0.f, 0.f, 0.f, 0.f};
    bf16x8 At[4][2], B0[2][2], B1[2][2];
    const char* cA = (const char*)g.A + (size_t)cur.pm * tstep; const char* cB = (const char*)g.Bt + (size_t)cur.pn * tstep;
    S.a_ready(cur);
    if constexpr (SP2) {
        PG8_STAGE(PG8_SB(0, 0), cB, voffB); PG8_STAGE(PG8_SB(0, 1), cB + hstep, voffB); PG8_STAGE(PG8_SA(0, 0), cA, voffA); PG8_STAGE(PG8_SA(0, 1), cA + hstep, voffA);
        if (wr == 1) PG8_BAR;
        PG8_WAIT_V(2); PG8_BAR;
        PG8_STAGE(PG8_SB(1, 0), cB + kstep, voffB); PG8_STAGE(PG8_SA(1, 0), cA + kstep, voffA); PG8_STAGE(PG8_SB(1, 1), cB + hstep + kstep, voffB);
        PG8_WAIT_V(6); PG8_BAR;
    } else {
        PG8_STAGE(PG8_SB(0, 0), cB, voffB); PG8_STAGE(PG8_SA(0, 0), cA, voffA); PG8_STAGE(PG8_SB(0, 1), cB + hstep, voffB); PG8_STAGE(PG8_SA(0, 1), cA + hstep, voffA);
        if (wr == 1) PG8_BAR;
        PG8_WAIT_V(4); PG8_BAR;
        PG8_STAGE(PG8_SB(1, 0), cB + kstep, voffB); PG8_STAGE(PG8_SA(1, 0), cA + kstep, voffA); PG8_STAGE(PG8_SB(1, 1), cB + hstep + kstep, voffB);
        PG8_WAIT_V(6); PG8_BAR;
    }
    for (;;) {
        const bool has_next = S.next(ui + 1, nxt);
        const char* nA = has_next ? (const char*)g.A + (size_t)nxt.pm * tstep : cA; const char* nB = has_next ? (const char*)g.Bt + (size_t)nxt.pn * tstep : cB;
        for (int t = 0; t < nt; t += 2) {
            const bool last = (t == nt - 2);
            const char* a1 = cA + (size_t)(t + 1) * kstep;
            const char* a2 = last ? nA : cA + (size_t)(t + 2) * kstep; const char* b2 = last ? nB : cB + (size_t)(t + 2) * kstep;
            const char* a3 = a2 + kstep; const char* b3 = b2 + kstep;
            if (last && has_next) S.a_ready(nxt);
            if constexpr (SP2) {
            PG8_LDB(B0, 0, 0); PG8_LDB(B1, 0, 1); PG8_SCHED; PG8_LDA(At, 0, 0); PG8_STAGE(PG8_SA(1, 1), a1 + hstep, voffA);
            PG8_WAIT_V(8); PG8_WAIT_L(0); PG8_BAR; PG8_MMA(0, 0, At, B0); PG8_MMA(0, 1, At, B1); PG8_BAR; PG8_SCHED;
            PG8_LDA(At, 0, 1); PG8_STAGE(PG8_SB(0, 0), b2, voffB); PG8_STAGE(PG8_SB(0, 1), b2 + hstep, voffB); PG8_STAGE(PG8_SA(0, 0), a2, voffA);
            PG8_WAIT_V(8); PG8_WAIT_L(0); PG8_BAR; PG8_MMA(1, 0, At, B0); PG8_MMA(1, 1, At, B1); PG8_BAR; PG8_SCHED;
            PG8_LDB(B0, 1, 0); PG8_LDB(B1, 1, 1); PG8_SCHED; PG8_LDA(At, 1, 0); PG8_STAGE(PG8_SA(0, 1), a2 + hstep, voffA);
            PG8_WAIT_V(8); PG8_WAIT_L(0); PG8_BAR; PG8_MMA(0, 0, At, B0); PG8_MMA(0, 1, At, B1); PG8_BAR; PG8_SCHED;
            PG8_LDA(At, 1, 1); PG8_STAGE(PG8_SB(1, 0), b3, voffB); PG8_STAGE(PG8_SB(1, 1), b3 + hstep, voffB); PG8_STAGE(PG8_SA(1, 0), a3, voffA);
            PG8_WAIT_V(8); PG8_WAIT_L(0); PG8_BAR; PG8_MMA(1, 0, At, B0); PG8_MMA(1, 1, At, B1); PG8_BAR; PG8_SCHED;
            } else {
            PG8_LDB(B0, 0, 0); PG8_SCHED; PG8_LDA(At, 0, 0); PG8_STAGE(PG8_SA(1, 1), a1 + hstep, voffA);
            PG8_WAIT_L(8); PG8_BAR; PG8_WAIT_L(0); PG8_MMA(0, 0, At, B0); PG8_BAR; PG8_SCHED;
            PG8_LDB(B1, 0, 1); PG8_STAGE(PG8_SB(0, 0), b2, voffB);
            PG8_BAR; PG8_WAIT_L(0); PG8_MMA(0, 1, At, B1); PG8_BAR;
            PG8_LDA(At, 0, 1); PG8_STAGE(PG8_SA(0, 0), a2, voffA);
            PG8_BAR; PG8_WAIT_L(0); PG8_MMA(1, 0, At, B0); PG8_BAR; PG8_SCHED;
            PG8_STAGE(PG8_SB(0, 1), b2 + hstep, voffB);
            PG8_WAIT_V(6); PG8_BAR; PG8_MMA(1, 1, At, B1); PG8_BAR;
            PG8_LDB(B0, 1, 0); PG8_SCHED; PG8_LDA(At, 1, 0); PG8_STAGE(PG8_SA(0, 1), a2 + hstep, voffA);
            PG8_WAIT_L(8); PG8_BAR; PG8_WAIT_L(0); PG8_MMA(0, 0, At, B0); PG8_BAR; PG8_SCHED;
            PG8_LDB(B1, 1, 1); PG8_STAGE(PG8_SB(1, 0), b3, voffB);
            PG8_BAR; PG8_WAIT_L(0); PG8_MMA(0, 1, At, B1); PG8_BAR;
            PG8_LDA(At, 1, 1); PG8_STAGE(PG8_SA(1, 0), a3, voffA);
            PG8_BAR; PG8_WAIT_L(0); PG8_MMA(1, 0, At, B0); PG8_BAR; PG8_SCHED;
            PG8_STAGE(PG8_SB(1, 1), b3 + hstep, voffB);
            PG8_WAIT_V(6); PG8_BAR; PG8_MMA(1, 1, At, B1); PG8_BAR;
            }
        }
        if constexpr (ALIGN_EPI) { if (wr == 0) PG8_BAR; }
        if constexpr (!Epi::AFTER_DRAIN) { E(acc, cur, wr, wc, fr, fq); S.done(cur); }
        if (!has_next) break;
#pragma unroll
        for (int a = 0; a < 2; ++a)
#pragma unroll
            for (int b = 0; b < 2; ++b)
#pragma unroll
                for (int m = 0; m < 4; ++m)
#pragma unroll
                    for (int n = 0; n < 2; ++n) acc[a][b][m][n] = (f32x4){0.f, 0.f, 0.f, 0.f};
        cur = nxt; cA = nA; cB = nB; ++ui;
        if constexpr (ALIGN_EPI) { if (wr == 1) PG8_BAR; }
    }
    PG8_WAIT_V(0);
    if constexpr (!ALIGN_EPI) { if (wr == 0) PG8_BAR; }
    PG8_BAR;
    if constexpr (Epi::AFTER_DRAIN) { E.fused(acc, cur, wr, wc, fr, fq, lds, wid, lane); S.done(cur); }
#undef PG8_SA
#undef PG8_SB
#undef PG8_STAGE
#undef PG8_LDA
#undef PG8_LDB
#undef PG8_MMA
#undef PG8_WAIT_V
#undef PG8_WAIT_L
#undef PG8_BAR
#undef PG8_SCHED
}
}

#define LAS __attribute__((address_space(3)))
typedef unsigned short bf16_t;
typedef float f32x4 __attribute__((ext_vector_type(4)));
typedef float f32x16 __attribute__((ext_vector_type(16)));
typedef unsigned u32x4 __attribute__((ext_vector_type(4)));
typedef unsigned u32x2 __attribute__((ext_vector_type(2)));
typedef short bf16x8 __attribute__((ext_vector_type(8)));
typedef short s16x4 __attribute__((ext_vector_type(4)));

constexpr int NP = 16384, NS = 32, MPAD = 16640, DM = 1024, INW = 9728, DFF = 4096, RQ = 16640, PCW = 5120;
constexpr float EPS = 1e-6f;
constexpr float C2 = 0.125f * 1.4426950408889634f;
constexpr int LDS_BYTES = 131072 + 256;
constexpr int NTHREADS = 512;

constexpr size_t O_YP = 0, O_YS = 16777216, O_KV128P = 16809984, O_KV512P = 17072128, O_KV2048P = 18120704, O_CONVP = 22315008,
                 O_KV128S = 22319104, O_KV512S = 26513408, O_KV2048S = 43290624, O_CONVS = 110399488;

constexpr size_t WS_WIN = 0;
constexpr size_t WS_WAO = WS_WIN + (size_t)INW * DM * 2;
constexpr size_t WS_WCO = WS_WAO + (size_t)DM * 512 * 2;
constexpr size_t WS_WO = WS_WCO + (size_t)DM * DM * 2;
constexpr size_t WS_WF1 = WS_WO + (size_t)DM * DM * 2;
constexpr size_t WS_WF2 = WS_WF1 + (size_t)DFF * DM * 2;
constexpr size_t WS_H = WS_WF2 + (size_t)DFF * DM * 2;
constexpr size_t QKV_SZ = (size_t)24 * RQ * 64 * 2;
constexpr size_t WS_Q = WS_H + (size_t)MPAD * DM * 2;
constexpr size_t WS_K = WS_Q + QKV_SZ, WS_V = WS_K + QKV_SZ;
constexpr size_t WS_HID = WS_Q;
constexpr size_t WS_PC = WS_V + QKV_SZ;
constexpr size_t WS_OG = WS_PC + (size_t)MPAD * PCW * 2;
constexpr size_t WS_LSE = WS_OG + (size_t)3 * NP * 512 * 2;
constexpr size_t WS_ATTN = WS_LSE + (size_t)3 * NP * 8 * 4;
constexpr size_t WS_CV = WS_ATTN + (size_t)MPAD * 512 * 2;
constexpr size_t WS_T = WS_CV + (size_t)MPAD * DM * 2;
constexpr size_t WS_MIXIN = WS_T + (size_t)MPAD * DM * 4;
constexpr size_t WS_MIX = WS_MIXIN + (size_t)MPAD * DM * 2;
constexpr size_t WS_H2 = WS_MIX + (size_t)MPAD * DM * 2;
constexpr size_t WS_F = WS_H2 + (size_t)MPAD * DM * 2;
constexpr size_t WS_SS = WS_F + (size_t)MPAD * DM * 2;
constexpr size_t WS_BAR = WS_SS + (size_t)2 * MPAD * 4;
constexpr size_t WS_SO = WS_BAR + 16384;
constexpr size_t WS_END = WS_SO + (size_t)(768 * 64 + 768) * 4;
static_assert((size_t)MPAD * DFF * 2 <= 3 * QKV_SZ, "hid overlay");

__device__ __forceinline__ unsigned pk_bf16(float lo, float hi) { return pg8::cvt_pk_bf16(lo, hi); }
__device__ __forceinline__ float bf_lo(unsigned w) { return __uint_as_float(w << 16); }
__device__ __forceinline__ float bf_hi(unsigned w) { return __uint_as_float(w & 0xffff0000u); }
__device__ __forceinline__ float bf2f(bf16_t v) { return __uint_as_float((unsigned)v << 16); }
__device__ __forceinline__ float sigm(float x) { return 1.f / (1.f + __expf(-x)); }
__device__ __forceinline__ void unpack8(const u32x4 w, float (&f)[8]) {
    f[0] = bf_lo(w.x); f[1] = bf_hi(w.x); f[2] = bf_lo(w.y); f[3] = bf_hi(w.y); f[4] = bf_lo(w.z); f[5] = bf_hi(w.z); f[6] = bf_lo(w.w); f[7] = bf_hi(w.w);
}
__device__ __forceinline__ u32x4 pack8(const float (&f)[8]) {
    u32x4 w; w.x = pk_bf16(f[0], f[1]); w.y = pk_bf16(f[2], f[3]); w.z = pk_bf16(f[4], f[5]); w.w = pk_bf16(f[6], f[7]); return w;
}
__device__ __forceinline__ float wave_sum(float v) {
#pragma unroll
    for (int o = 1; o < 64; o <<= 1) v += __shfl_xor(v, o);
    return v;
}
__device__ __forceinline__ float wave_max(float v) {
#pragma unroll
    for (int o = 1; o < 64; o <<= 1) v = fmaxf(v, __shfl_xor(v, o));
    return v;
}

struct EpiIn {
    static constexpr bool PERM = true, AFTER_DRAIN = false;
    bf16_t *Q, *PC;
    __device__ __forceinline__ void operator()(const f32x4 (&acc)[2][2][4][2], const pg8::Unit& u, int wr, int wc, int fr, int fq) const {
        const int colt = u.pn * 256, row0 = u.pm * 256 + wr * 64 + fr;
        if (colt < 4608) {
            const int which = colt / 1536, cin = colt - which * 1536;
            bf16_t* base = Q + (size_t)which * (QKV_SZ / 2);
            const int g = cin >> 9, sh = 2 * g;
#pragma unroll
            for (int ai = 0; ai < 2; ++ai)
#pragma unroll
                for (int m = 0; m < 4; ++m) {
                    const int row = row0 + ai * 128 + m * 16;
                    const int rowp = row < NP ? ((row & ~8191) | ((row & ((1 << sh) - 1)) << (13 - sh)) | ((row & 8191) >> sh)) : row;
#pragma unroll
                    for (int bj = 0; bj < 2; ++bj) {
                        const int cgc = cin + bj * 128 + wc * 32 + 8 * fq, h = (cgc >> 6) & 7, d = cgc & 63;
                        const f32x4 v0 = acc[ai][bj][m][0], v1 = acc[ai][bj][m][1];
                        u32x4 w; w.x = pk_bf16(v0[0], v0[1]); w.y = pk_bf16(v0[2], v0[3]); w.z = pk_bf16(v1[0], v1[1]); w.w = pk_bf16(v1[2], v1[3]);
                        *(u32x4*)(base + ((size_t)(g * 8 + h) * RQ + rowp) * 64 + d) = w;
                    }
                }
        } else {
            const int c0 = colt - 4608 + wc * 32 + 8 * fq;
#pragma unroll
            for (int ai = 0; ai < 2; ++ai)
#pragma unroll
                for (int m = 0; m < 4; ++m) {
                    bf16_t* rowp = PC + (size_t)(row0 + ai * 128 + m * 16) * PCW + c0;
#pragma unroll
                    for (int bj = 0; bj < 2; ++bj) {
                        const f32x4 v0 = acc[ai][bj][m][0], v1 = acc[ai][bj][m][1];
                        u32x4 w; w.x = pk_bf16(v0[0], v0[1]); w.y = pk_bf16(v0[2], v0[3]); w.z = pk_bf16(v1[0], v1[1]); w.w = pk_bf16(v1[2], v1[3]);
                        *(u32x4*)(rowp + bj * 128) = w;
                    }
                }
        }
    }
};

struct EpiGateA {
    static constexpr bool PERM = true, AFTER_DRAIN = false;
    const bf16_t* PC; bf16_t* T;
    __device__ __forceinline__ void operator()(const f32x4 (&acc)[2][2][4][2], const pg8::Unit& u, int wr, int wc, int fr, int fq) const {
        const int row0 = u.pm * 256 + wr * 64 + fr, col0 = u.pn * 256 + wc * 32 + 8 * fq;
#pragma unroll
        for (int ai = 0; ai < 2; ++ai)
#pragma unroll
            for (int m = 0; m < 4; ++m) {
                const int row = row0 + ai * 128 + m * 16;
#pragma unroll
                for (int bj = 0; bj < 2; ++bj) {
                    const int col = col0 + bj * 128;
                    float gt[8]; unpack8(*(const u32x4*)(PC + (size_t)row * PCW + 3072 + col), gt);
                    const f32x4 v0 = acc[ai][bj][m][0], v1 = acc[ai][bj][m][1];
                    float o[8];
#pragma unroll
                    for (int j = 0; j < 4; ++j) { o[j] = sigm(gt[j]) * v0[j]; o[4 + j] = sigm(gt[4 + j]) * v1[j]; }
                    *(u32x4*)(T + (size_t)row * DM + col) = pack8(o);
                }
            }
    }
};

struct EpiGateC {
    static constexpr bool PERM = true, AFTER_DRAIN = false;
    const bf16_t* PC; const bf16_t* T; bf16_t* O;
    __device__ __forceinline__ void operator()(const f32x4 (&acc)[2][2][4][2], const pg8::Unit& u, int wr, int wc, int fr, int fq) const {
        const int row0 = u.pm * 256 + wr * 64 + fr, col0 = u.pn * 256 + wc * 32 + 8 * fq;
#pragma unroll
        for (int ai = 0; ai < 2; ++ai)
#pragma unroll
            for (int m = 0; m < 4; ++m) {
                const int row = row0 + ai * 128 + m * 16;
#pragma unroll
                for (int bj = 0; bj < 2; ++bj) {
                    const int col = col0 + bj * 128;
                    float gt[8]; unpack8(*(const u32x4*)(PC + (size_t)row * PCW + 4096 + col), gt);
                    float tt[8]; unpack8(*(const u32x4*)(T + (size_t)row * DM + col), tt);
                    const f32x4 v0 = acc[ai][bj][m][0], v1 = acc[ai][bj][m][1];
                    float o[8];
#pragma unroll
                    for (int j = 0; j < 4; ++j) { o[j] = tt[j] + sigm(gt[j]) * v0[j]; o[4 + j] = tt[4 + j] + sigm(gt[4 + j]) * v1[j]; }
                    *(u32x4*)(O + (size_t)row * DM + col) = pack8(o);
                }
            }
    }
};

struct EpiSS {
    static constexpr bool PERM = true, AFTER_DRAIN = false;
    bf16_t* O; float* ss;
    __device__ __forceinline__ void operator()(const f32x4 (&acc)[2][2][4][2], const pg8::Unit& u, int wr, int wc, int fr, int fq) const {
        const int row0 = u.pm * 256 + wr * 64 + fr, col0 = u.pn * 256 + wc * 32 + 8 * fq;
#pragma unroll
        for (int ai = 0; ai < 2; ++ai)
#pragma unroll
            for (int m = 0; m < 4; ++m) {
                const int row = row0 + ai * 128 + m * 16;
                float s = 0.f;
#pragma unroll
                for (int bj = 0; bj < 2; ++bj) {
                    const f32x4 v0 = acc[ai][bj][m][0], v1 = acc[ai][bj][m][1];
                    u32x4 w; w.x = pk_bf16(v0[0], v0[1]); w.y = pk_bf16(v0[2], v0[3]); w.z = pk_bf16(v1[0], v1[1]); w.w = pk_bf16(v1[2], v1[3]);
                    *(u32x4*)(O + (size_t)row * DM + col0 + bj * 128) = w;
#pragma unroll
                    for (int j = 0; j < 4; ++j) s += v0[j] * v0[j] + v1[j] * v1[j];
                }
                s += __shfl_xor(s, 16); s += __shfl_xor(s, 32);
                if (fq == 0) atomicAdd(ss + row, s);
            }
    }
};

struct EpiRelu2 {
    static constexpr bool PERM = true, AFTER_DRAIN = false;
    bf16_t* O;
    __device__ __forceinline__ void operator()(const f32x4 (&acc)[2][2][4][2], const pg8::Unit& u, int wr, int wc, int fr, int fq) const {
        const int row0 = u.pm * 256 + wr * 64 + fr, col0 = u.pn * 256 + wc * 32 + 8 * fq;
#pragma unroll
        for (int ai = 0; ai < 2; ++ai)
#pragma unroll
            for (int m = 0; m < 4; ++m) {
                bf16_t* rowp = O + (size_t)(row0 + ai * 128 + m * 16) * DFF + col0;
#pragma unroll
                for (int bj = 0; bj < 2; ++bj) {
                    f32x4 v0 = acc[ai][bj][m][0], v1 = acc[ai][bj][m][1];
#pragma unroll
                    for (int j = 0; j < 4; ++j) { const float a = fmaxf(v0[j], 0.f), b = fmaxf(v1[j], 0.f); v0[j] = a * a; v1[j] = b * b; }
                    u32x4 w; w.x = pk_bf16(v0[0], v0[1]); w.y = pk_bf16(v0[2], v0[3]); w.z = pk_bf16(v1[0], v1[1]); w.w = pk_bf16(v1[2], v1[3]);
                    *(u32x4*)(rowp + bj * 128) = w;
                }
            }
    }
};

__device__ __forceinline__ void transpose_item(const float* W, int K, int N, bf16_t* WT, LAS float* scr, int item, int lane) {
    const int nblk = N >> 5, kb = item / nblk, nb = item - kb * nblk, k0 = 64 * kb, n0 = 32 * nb;
#pragma unroll 8
    for (int i = 0; i < 32; ++i) { const int kk = 2 * i + (lane >> 5); scr[kk * 33 + (lane & 31)] = W[(size_t)(k0 + kk) * N + n0 + (lane & 31)]; }
    asm volatile("s_waitcnt lgkmcnt(0)" ::: "memory");
    const int c = lane & 7;
#pragma unroll
    for (int j = 0; j < 4; ++j) {
        const int n = (lane >> 3) + 8 * j; const LAS float* s = scr + (8 * c) * 33 + n;
        u32x4 o; o.x = pk_bf16(s[0 * 33], s[1 * 33]); o.y = pk_bf16(s[2 * 33], s[3 * 33]); o.z = pk_bf16(s[4 * 33], s[5 * 33]); o.w = pk_bf16(s[6 * 33], s[7 * 33]);
        *(u32x4*)(WT + (size_t)(n0 + n) * K + k0 + 8 * c) = o;
    }
    asm volatile("s_waitcnt lgkmcnt(0)" ::: "memory");
}

__device__ __forceinline__ void rms_row_bf16(const float* xrow, const float* g, bf16_t* orow, int lane) {
    const f32x4* xr = (const f32x4*)xrow + lane; f32x4 v[4]; float s = 0.f;
#pragma unroll
    for (int j = 0; j < 4; ++j) { v[j] = xr[64 * j]; s += (v[j].x * v[j].x + v[j].y * v[j].y) + (v[j].z * v[j].z + v[j].w * v[j].w); }
    const float rs = rsqrtf(wave_sum(s) * (1.f / DM) + EPS);
#pragma unroll
    for (int j = 0; j < 4; ++j) {
        const f32x4 gg = ((const f32x4*)g)[lane + 64 * j];
        u32x2 o; o.x = pk_bf16(v[j].x * rs * gg.x, v[j].y * rs * gg.y); o.y = pk_bf16(v[j].z * rs * gg.z, v[j].w * rs * gg.w);
        ((u32x2*)orow)[lane + 64 * j] = o;
    }
}

__device__ __forceinline__ void shift_copy(const float* src, float* dst, int L, size_t gtid, size_t gthreads) {
    const size_t per_b = (size_t)L * 256, total = 32 * per_b, valid = (size_t)(L - 1) * 256;
    const f32x4* s4 = (const f32x4*)src; f32x4* d4 = (f32x4*)dst;
#pragma unroll 4
    for (size_t i = gtid; i < total; i += gthreads) {
        const size_t rem = i & (per_b - 1);
        if (rem < valid) { const f32x4 v = __builtin_nontemporal_load(s4 + i + 256); __builtin_nontemporal_store(v, d4 + i); }
    }
}

__device__ __forceinline__ s16x4 vtr(const LAS unsigned char* p) {
    typedef short v4i16_t __attribute__((ext_vector_type(4)));
    return __builtin_bit_cast(s16x4, __builtin_amdgcn_ds_read_tr16_b64_v4i16((LAS v4i16_t*)p));
}
__device__ __forceinline__ int crow(int r, int hi) { return (r & 3) + 8 * (r >> 2) + 4 * hi; }

__device__ __forceinline__ void attn_prompt_task(int task, const bf16_t* Qb, const bf16_t* Kb, const bf16_t* Vb, bf16_t* OG, float* LSE, LAS unsigned char* wl, int lane) {
    const int gh = task >> 9, blk = task & 511, g = gh >> 3, h = gh & 7, sh = 2 * g;
    const int R0 = blk << 5, b = R0 >> 13, off = R0 & 8191, lrb = 13 - sh;
    const int c = off >> lrb, m0 = off & ((1 << lrb) - 1);
    const int qi = lane & 31, hi = lane >> 5;
    const size_t hb = (size_t)gh * RQ;
    bf16x8 qf[4];
    { const bf16_t* qp = Qb + (hb + R0 + qi) * 64 + hi * 8;
#pragma unroll
      for (int ks = 0; ks < 4; ++ks) qf[ks] = *(const bf16x8*)(qp + ks * 16); }
    const int jfirst = m0 >= 128 ? 0 : ((128 - m0) >> 5);
    f32x16 O0, O1;
#pragma unroll
    for (int i = 0; i < 16; ++i) { O0[i] = 0.f; O1[i] = 0.f; }
    float m_run = -1e30f, l_run = 0.f;
    const int kwo = (lane >> 3) * 144 + (lane & 7) * 16;
    const int vwo = 4608 + ((lane & 7) >> 2) * 2048 + (lane >> 3) * 64 + (lane & 3) * 16;
    const int kro = qi * 144 + hi * 16;
    const int vro = 4608 + (4 * hi + ((lane & 15) >> 2)) * 64 + ((lane >> 4) & 1) * 32 + (lane & 3) * 8;
    u32x4 krA[4], vrA[4], krB[4], vrB[4];
    const size_t eb = (hb + (size_t)(R0 - 128)) * 64 + lane * 8;
    {
#pragma unroll
        for (int it = 0; it < 4; ++it) { krA[it] = *(const u32x4*)(Kb + eb + (size_t)jfirst * 2048 + it * 512); vrA[it] = *(const u32x4*)(Vb + eb + (size_t)jfirst * 2048 + it * 512); }
        if (jfirst < 4) {
#pragma unroll
            for (int it = 0; it < 4; ++it) { krB[it] = *(const u32x4*)(Kb + eb + (size_t)(jfirst + 1) * 2048 + it * 512); vrB[it] = *(const u32x4*)(Vb + eb + (size_t)(jfirst + 1) * 2048 + it * 512); }
        }
    }
#define ATT_BLOCK(J, KR, VR) do { const int j = (J); \
        asm volatile("" ::: "memory"); \
        _Pragma("unroll") for (int it = 0; it < 4; ++it) { *(LAS u32x4*)(wl + kwo + it * 8 * 144) = KR[it]; *(LAS u32x4*)(wl + vwo + it * 8 * 64) = VR[it]; } \
        asm volatile("" ::: "memory"); \
        if (j + 2 < 5) { _Pragma("unroll") for (int it = 0; it < 4; ++it) { KR[it] = *(const u32x4*)(Kb + eb + (size_t)(j + 2) * 2048 + it * 512); VR[it] = *(const u32x4*)(Vb + eb + (size_t)(j + 2) * 2048 + it * 512); } } \
        f32x16 S; \
        _Pragma("unroll") for (int i = 0; i < 16; ++i) S[i] = 0.f; \
        _Pragma("unroll") for (int ks = 0; ks < 4; ++ks) { const bf16x8 kf = *(const LAS bf16x8*)(wl + kro + ks * 32); S = __builtin_amdgcn_mfma_f32_32x32x16_bf16(kf, qf[ks], S, 0, 0, 0); } \
        float mx = -1e30f; \
        _Pragma("unroll") for (int i = 0; i < 16; ++i) { const int kk = crow(i, hi); float sv = S[i] * C2; if (j == 0 && kk < qi) sv = -1e30f; if (j == 4 && kk > qi) sv = -1e30f; S[i] = sv; mx = fmaxf(mx, sv); } \
        mx = fmaxf(mx, __shfl_xor(mx, 32)); \
        const float m_new = fmaxf(m_run, mx), corr = __builtin_amdgcn_exp2f(m_run - m_new); \
        float ps = 0.f; \
        _Pragma("unroll") for (int i = 0; i < 16; ++i) { const float p = __builtin_amdgcn_exp2f(S[i] - m_new); S[i] = p; ps += p; } \
        l_run = l_run * corr + ps; m_run = m_new; \
        _Pragma("unroll") for (int i = 0; i < 16; ++i) { O0[i] *= corr; O1[i] *= corr; } \
        bf16x8 pb[2]; \
        _Pragma("unroll") for (int s2 = 0; s2 < 2; ++s2) { u32x4 w; w.x = pk_bf16(S[8 * s2 + 0], S[8 * s2 + 1]); w.y = pk_bf16(S[8 * s2 + 2], S[8 * s2 + 3]); w.z = pk_bf16(S[8 * s2 + 4], S[8 * s2 + 5]); w.w = pk_bf16(S[8 * s2 + 6], S[8 * s2 + 7]); pb[s2] = __builtin_bit_cast(bf16x8, w); } \
        _Pragma("unroll") for (int s2 = 0; s2 < 2; ++s2) { _Pragma("unroll") for (int db = 0; db < 2; ++db) { \
                const s16x4 av = vtr(wl + vro + db * 2048 + s2 * 1024), bq = vtr(wl + vro + db * 2048 + s2 * 1024 + 512); \
                bf16x8 vf; vf[0] = av[0]; vf[1] = av[1]; vf[2] = av[2]; vf[3] = av[3]; vf[4] = bq[0]; vf[5] = bq[1]; vf[6] = bq[2]; vf[7] = bq[3]; \
                if (db == 0) O0 = __builtin_amdgcn_mfma_f32_32x32x16_bf16(vf, pb[s2], O0, 0, 0, 0); else O1 = __builtin_amdgcn_mfma_f32_32x32x16_bf16(vf, pb[s2], O1, 0, 0, 0); } } \
    } while (0)
    for (int j0 = jfirst; j0 < 5; j0 += 2) {
        ATT_BLOCK(j0, krA, vrA);
        if (j0 + 1 < 5) ATT_BLOCK(j0 + 1, krB, vrB);
    }
#undef ATT_BLOCK
    const float l_tot = l_run + __shfl_xor(l_run, 32), inv = 1.f / l_tot;
    const int rown = (b << 13) + (((m0 + qi) << sh) | c);
    bf16_t* op = OG + ((size_t)g * NP + rown) * 512 + h * 64 + 4 * hi;
#pragma unroll
    for (int i4 = 0; i4 < 4; ++i4) {
        u32x2 w0, w1;
        w0.x = pk_bf16(O0[4 * i4 + 0] * inv, O0[4 * i4 + 1] * inv); w0.y = pk_bf16(O0[4 * i4 + 2] * inv, O0[4 * i4 + 3] * inv);
        w1.x = pk_bf16(O1[4 * i4 + 0] * inv, O1[4 * i4 + 1] * inv); w1.y = pk_bf16(O1[4 * i4 + 2] * inv, O1[4 * i4 + 3] * inv);
        *(u32x2*)(op + 8 * i4) = w0; *(u32x2*)(op + 32 + 8 * i4) = w1;
    }
    if (hi == 0) LSE[((size_t)g * NP + rown) * 8 + h] = m_run + log2f(l_tot);
}

__device__ __forceinline__ void attn_sample_task(int task, const bf16_t* Qb, const bf16_t* Kb, const bf16_t* Vb,
                                                 const float* c0, const float* c1, const float* c2, float* SO, float* SL, LAS float* pl, int lane) {
    const int g = task >> 8, b = (task >> 3) & 31, h = task & 7, sh = 2 * g, L = 128 << sh;
    const unsigned long long ca = g == 0 ? (unsigned long long)c0 : (g == 1 ? (unsigned long long)c1 : (unsigned long long)c2);
    const float* cache = (const float*)ca;
    const size_t rowq = ((size_t)(g * 8 + h) * RQ + NP + b) * 64;
    const float qv = bf2f(Qb[rowq + lane]);
    const f32x4* k0p = (const f32x4*)(cache + ((size_t)(b * L + (lane << sh)) * 2) * 512 + h * 64);
    const f32x4* k1p = (const f32x4*)(cache + ((size_t)(b * L + ((lane + 64) << sh)) * 2) * 512 + h * 64);
    f32x4 ka[16], kb[16];
#pragma unroll
    for (int d4 = 0; d4 < 16; ++d4) { ka[d4] = k0p[d4]; kb[d4] = k1p[d4]; }
    float s0 = 0.f, s1 = 0.f;
#pragma unroll
    for (int d4 = 0; d4 < 16; ++d4) {
        const float q0 = __int_as_float(__builtin_amdgcn_readlane(__float_as_int(qv), 4 * d4 + 0)), q1 = __int_as_float(__builtin_amdgcn_readlane(__float_as_int(qv), 4 * d4 + 1));
        const float q2 = __int_as_float(__builtin_amdgcn_readlane(__float_as_int(qv), 4 * d4 + 2)), q3 = __int_as_float(__builtin_amdgcn_readlane(__float_as_int(qv), 4 * d4 + 3));
        s0 += ka[d4].x * q0 + ka[d4].y * q1 + ka[d4].z * q2 + ka[d4].w * q3;
        s1 += kb[d4].x * q0 + kb[d4].y * q1 + kb[d4].z * q2 + kb[d4].w * q3;
    }
    const float kn = bf2f(Kb[rowq + lane]);
    float sn = wave_sum(kn * qv);
    s0 *= C2; s1 *= C2; sn *= C2;
    const float mx = fmaxf(wave_max(fmaxf(s0, s1)), sn);
    const float p0 = exp2f(s0 - mx), p1 = exp2f(s1 - mx), pn = exp2f(sn - mx);
    const float l = wave_sum(p0 + p1) + pn;
    asm volatile("" ::: "memory");
    pl[lane] = p0; pl[64 + lane] = p1;
    asm volatile("s_waitcnt lgkmcnt(0)" ::: "memory");
    const int kq = lane >> 4, d4l = lane & 15;
    const f32x4* vp4 = (const f32x4*)(cache + ((size_t)(b * L) * 2 + 1) * 512 + h * 64) + d4l;
    f32x4 vv[32];
#pragma unroll
    for (int i = 0; i < 32; ++i) vv[i] = vp4[(size_t)((4 * i + kq) << sh) * 256];
    f32x4 oa = {0.f, 0.f, 0.f, 0.f};
#pragma unroll
    for (int i = 0; i < 32; ++i) oa += vv[i] * pl[4 * i + kq];
    asm volatile("s_waitcnt lgkmcnt(0)" ::: "memory");
#pragma unroll
    for (int e = 0; e < 4; ++e) { oa[e] += __shfl_xor(oa[e], 16); oa[e] += __shfl_xor(oa[e], 32); }
    if (lane < 16) {
        const u32x2 vn = *(const u32x2*)(Vb + rowq + 4 * lane);
        const float il = 1.f / l;
        f32x4 o; o.x = (oa.x + pn * bf_lo(vn.x)) * il; o.y = (oa.y + pn * bf_hi(vn.x)) * il; o.z = (oa.z + pn * bf_lo(vn.y)) * il; o.w = (oa.w + pn * bf_hi(vn.y)) * il;
        ((f32x4*)(SO + (size_t)task * 64))[lane] = o;
        if (lane == 0) SL[task] = mx + log2f(l);
    }
}

template <int K>
__device__ __forceinline__ void skinny_tile(const bf16_t* A, int lda, const bf16_t* Bt, int n0, LAS float* red, int wave, int lane, float& r0, float& r1) {
    constexpr int KW = K / 8, NS16 = KW / 16;
    const bf16_t* ap = A + (size_t)(lane & 31) * lda + wave * KW + (lane >> 5) * 8;
    const bf16_t* bp = Bt + (size_t)(n0 + (lane & 31)) * K + wave * KW + (lane >> 5) * 8;
    f32x16 acc;
#pragma unroll
    for (int i = 0; i < 16; ++i) acc[i] = 0.f;
    constexpr int UN = NS16 < 8 ? NS16 : 8;
    for (int s0 = 0; s0 < NS16; s0 += UN) {
        bf16x8 av[UN], bv[UN];
#pragma unroll
        for (int u = 0; u < UN; ++u) { av[u] = *(const bf16x8*)(ap + (s0 + u) * 16); bv[u] = *(const bf16x8*)(bp + (s0 + u) * 16); }
#pragma unroll
        for (int u = 0; u < UN; ++u) acc = __builtin_amdgcn_mfma_f32_32x32x16_bf16(av[u], bv[u], acc, 0, 0, 0);
    }
    const int hi = lane >> 5;
#pragma unroll
    for (int i = 0; i < 16; ++i) red[wave * 1024 + crow(i, hi) * 32 + (lane & 31)] = acc[i];
    __syncthreads();
    const int t = threadIdx.x;
    float a0 = 0.f, a1 = 0.f;
#pragma unroll
    for (int w = 0; w < 8; ++w) { a0 += red[w * 1024 + 2 * t]; a1 += red[w * 1024 + 2 * t + 1]; }
    r0 = a0; r1 = a1;
    __syncthreads();
}

__device__ __forceinline__ void conv_prompt_task(int task, const bf16_t* PC, const float* cw, bf16_t* CV, float* out, int lane) {
    const int strip = task >> 1, col = (task & 1) * 512 + lane * 8;
    const int row_base = strip * 16, t0 = row_base & 8191, b = row_base >> 13;
    float w0[8], w1[8], w2[8], u1[8], u2[8];
    { const f32x4 a = *(const f32x4*)(cw + col), bq = *(const f32x4*)(cw + col + 4);
      const f32x4 c = *(const f32x4*)(cw + 1024 + col), d = *(const f32x4*)(cw + 1024 + col + 4);
      const f32x4 e = *(const f32x4*)(cw + 2048 + col), f = *(const f32x4*)(cw + 2048 + col + 4);
#pragma unroll
      for (int j = 0; j < 4; ++j) { w0[j] = a[j]; w0[4 + j] = bq[j]; w1[j] = c[j]; w1[4 + j] = d[j]; w2[j] = e[j]; w2[4 + j] = f[j]; } }
    if (t0 == 0) {
#pragma unroll
        for (int j = 0; j < 8; ++j) { u1[j] = 0.f; u2[j] = 0.f; }
    } else {
        float a[8], bq[8];
        unpack8(*(const u32x4*)(PC + (size_t)(row_base - 2) * PCW + 1024 + col), a); unpack8(*(const u32x4*)(PC + (size_t)(row_base - 2) * PCW + 2048 + col), bq);
#pragma unroll
        for (int j = 0; j < 8; ++j) u2[j] = a[j] * bq[j];
        unpack8(*(const u32x4*)(PC + (size_t)(row_base - 1) * PCW + 1024 + col), a); unpack8(*(const u32x4*)(PC + (size_t)(row_base - 1) * PCW + 2048 + col), bq);
#pragma unroll
        for (int j = 0; j < 8; ++j) u1[j] = a[j] * bq[j];
    }
#pragma unroll 4
    for (int r = 0; r < 16; ++r) {
        const size_t row = (size_t)(row_base + r);
        float cc[8], ch[8], cb[8], o[8];
        unpack8(*(const u32x4*)(PC + row * PCW + 1024 + col), cc); unpack8(*(const u32x4*)(PC + row * PCW + 2048 + col), ch); unpack8(*(const u32x4*)(PC + row * PCW + col), cb);
#pragma unroll
        for (int j = 0; j < 8; ++j) { const float u = cc[j] * ch[j]; o[j] = cb[j] * (w0[j] * u2[j] + w1[j] * u1[j] + w2[j] * u); u2[j] = u1[j]; u1[j] = u; }
        *(u32x4*)(CV + row * DM + col) = pack8(o);
        if (t0 + r >= 8190) {
            float* op = out + O_CONVP + (size_t)(b * 2 + (t0 + r - 8190)) * 1024 + col;
            f32x4 x0, x1;
#pragma unroll
            for (int j = 0; j < 4; ++j) { x0[j] = u1[j]; x1[j] = u1[4 + j]; }
            *(f32x4*)op = x0; *(f32x4*)(op + 4) = x1;
        }
    }
}

__device__ __forceinline__ void norm1_row(const float* xrow, const bf16_t* mrow, float ss, const float* gpost, const float* gpre, bf16_t* x1row, bf16_t* h2row, int lane) {
    const float rs1 = rsqrtf(ss * (1.f / DM) + EPS);
    f32x4 v[4]; float s = 0.f;
#pragma unroll
    for (int j = 0; j < 4; ++j) {
        const f32x4 xv = ((const f32x4*)xrow)[lane + 64 * j], gp = ((const f32x4*)gpost)[lane + 64 * j];
        const u32x2 mw = ((const u32x2*)mrow)[lane + 64 * j];
        v[j].x = xv.x + bf_lo(mw.x) * rs1 * gp.x; v[j].y = xv.y + bf_hi(mw.x) * rs1 * gp.y; v[j].z = xv.z + bf_lo(mw.y) * rs1 * gp.z; v[j].w = xv.w + bf_hi(mw.y) * rs1 * gp.w;
        s += (v[j].x * v[j].x + v[j].y * v[j].y) + (v[j].z * v[j].z + v[j].w * v[j].w);
    }
    const float rs2 = rsqrtf(wave_sum(s) * (1.f / DM) + EPS);
#pragma unroll
    for (int j = 0; j < 4; ++j) {
        const f32x4 gg = ((const f32x4*)gpre)[lane + 64 * j];
        { u32x2 xo; xo.x = pk_bf16(v[j].x, v[j].y); xo.y = pk_bf16(v[j].z, v[j].w); ((u32x2*)x1row)[lane + 64 * j] = xo; }
        u32x2 o; o.x = pk_bf16(v[j].x * rs2 * gg.x, v[j].y * rs2 * gg.y); o.y = pk_bf16(v[j].z * rs2 * gg.z, v[j].w * rs2 * gg.w);
        ((u32x2*)h2row)[lane + 64 * j] = o;
    }
}
__device__ __forceinline__ void norm2_row(float* yrow, const bf16_t* x1row, const bf16_t* frow, float ss, const float* gpost, int lane) {
    const float rs = rsqrtf(ss * (1.f / DM) + EPS);
#pragma unroll
    for (int j = 0; j < 4; ++j) {
        const u32x2 xw = ((const u32x2*)x1row)[lane + 64 * j]; const f32x4 gp = ((const f32x4*)gpost)[lane + 64 * j];
        const u32x2 mw = ((const u32x2*)frow)[lane + 64 * j];
        f32x4 xv;
        xv.x = bf_lo(xw.x) + bf_lo(mw.x) * rs * gp.x; xv.y = bf_hi(xw.x) + bf_hi(mw.x) * rs * gp.y; xv.z = bf_lo(xw.y) + bf_lo(mw.y) * rs * gp.z; xv.w = bf_hi(xw.y) + bf_hi(mw.y) * rs * gp.w;
        ((f32x4*)yrow)[lane + 64 * j] = xv;
    }
}

#define WIN ((bf16_t*)(ws + WS_WIN))
#define WAO ((bf16_t*)(ws + WS_WAO))
#define WCO ((bf16_t*)(ws + WS_WCO))
#define WO ((bf16_t*)(ws + WS_WO))
#define WF1 ((bf16_t*)(ws + WS_WF1))
#define WF2 ((bf16_t*)(ws + WS_WF2))
#define H ((bf16_t*)(ws + WS_H))
#define Qb ((bf16_t*)(ws + WS_Q))
#define Kb ((bf16_t*)(ws + WS_K))
#define Vb ((bf16_t*)(ws + WS_V))
#define HID ((bf16_t*)(ws + WS_HID))
#define PC ((bf16_t*)(ws + WS_PC))
#define OG ((bf16_t*)(ws + WS_OG))
#define LSE ((float*)(ws + WS_LSE))
#define ATTN ((bf16_t*)(ws + WS_ATTN))
#define CV ((bf16_t*)(ws + WS_CV))
#define T ((bf16_t*)(ws + WS_T))
#define X1 ((bf16_t*)(ws + WS_T))
#define MIXIN ((bf16_t*)(ws + WS_MIXIN))
#define MIX ((bf16_t*)(ws + WS_MIX))
#define H2 ((bf16_t*)(ws + WS_H2))
#define Fb ((bf16_t*)(ws + WS_F))
#define SS ((float*)(ws + WS_SS))
#ifndef REP_P1
#define REP_P1 1
#endif
#ifndef REP_SYNC
#define REP_SYNC 1
#endif
#ifndef REP_P0
#define REP_P0 1
#endif
#ifndef REP_P2
#define REP_P2 1
#endif
constexpr int CPY_N = 16;
constexpr size_t CPY_T0 = (size_t)32 * 128 * 256, CPY_T1 = CPY_T0 + (size_t)32 * 512 * 256, CPY_TOT = CPY_T1 + (size_t)32 * 2048 * 256;
struct CopyOrder : pg8::StaticOrder {
    const f32x4 *s0, *s1, *s2; f32x4 *d0, *d1, *d2;
    mutable int ui;
    __device__ __forceinline__ bool next(int i, pg8::Unit& u) const {
        if (!pg8::StaticOrder::next(i, u)) return false;
        u.pn += 18; if (u.pn >= INW / 256) u.pn -= INW / 256;
        return true;
    }
    __device__ __forceinline__ void done(const pg8::Unit&) const {
        const size_t base = ((size_t)ui * G + c) * (size_t)(CPY_N * NTHREADS) + threadIdx.x; ++ui;
        f32x4 v[CPY_N];
#pragma unroll
        for (int j = 0; j < CPY_N; ++j) {
            const size_t f = base + (size_t)j * NTHREADS;
            if (f < CPY_T0) { if ((f & (128 * 256 - 1)) < 127 * 256) v[j] = __builtin_nontemporal_load(s0 + f + 256); }
            else if (f < CPY_T1) { const size_t r = f - CPY_T0; if ((r & (512 * 256 - 1)) < 511 * 256) v[j] = __builtin_nontemporal_load(s1 + r + 256); }
            else if (f < CPY_TOT) { const size_t r = f - CPY_T1; if ((r & (2048 * 256 - 1)) < 2047 * 256) v[j] = __builtin_nontemporal_load(s2 + r + 256); }
        }
#pragma unroll
        for (int j = 0; j < CPY_N; ++j) {
            const size_t f = base + (size_t)j * NTHREADS;
            if (f < CPY_T0) { if ((f & (128 * 256 - 1)) < 127 * 256) __builtin_nontemporal_store(v[j], d0 + f); }
            else if (f < CPY_T1) { const size_t r = f - CPY_T0; if ((r & (512 * 256 - 1)) < 511 * 256) __builtin_nontemporal_store(v[j], d1 + r); }
            else if (f < CPY_TOT) { const size_t r = f - CPY_T1; if ((r & (2048 * 256 - 1)) < 2047 * 256) __builtin_nontemporal_store(v[j], d2 + r); }
        }
        asm volatile("s_waitcnt vmcnt(0)" ::: "memory");
    }
};
constexpr size_t CPY_HOOK = (size_t)CPY_N * NTHREADS * ((NP / 256) * (INW / 256));
static_assert(CPY_HOOK >= CPY_T1 && CPY_HOOK <= CPY_TOT, "the tail lies in the third cache");

#define XB_TMO      128
#define XB_XCNT(j)  (256  + 64 * (j))
#define XB_XSUB(j)  (1280 + 64 * (j))
#define XB_XGEN(j)  (2304 + 64 * (j))
#define XB_TOP      3328
#define XB_TOPGEN   3392
#define XCD_BAR_WORDS 3456
#define XB_SPIN_CAP (1u << 18)

__device__ __forceinline__ unsigned xb_ld(unsigned* p)              { return __hip_atomic_load(p, __ATOMIC_RELAXED, __HIP_MEMORY_SCOPE_AGENT); }
__device__ __forceinline__ unsigned xb_add(unsigned* p, unsigned v) { return __hip_atomic_fetch_add(p, v, __ATOMIC_RELAXED, __HIP_MEMORY_SCOPE_AGENT); }
__device__ __forceinline__ unsigned xb_xcc_id() { return (unsigned)__builtin_amdgcn_s_getreg((3 << 11) | 20) & 0xFu; }
#define XB_SPIN(cond, bar) do { unsigned _sp = 0; while (cond) { __builtin_amdgcn_s_sleep(1); \
    if ((++_sp & 255u) == 0u) { if (xb_ld(&(bar)[XB_TMO])) break; if (_sp > XB_SPIN_CAP) { atomicAdd(&(bar)[XB_TMO], 1u); break; } } } } while (0)

struct XcdBarrier {
    unsigned* bar; unsigned x;
    volatile LAS unsigned* st;
};

__device__ __forceinline__ XcdBarrier xcd_barrier_post(unsigned* bar, volatile LAS unsigned* st) {
    XcdBarrier b; b.bar = bar; b.x = xb_xcc_id(); b.st = st;
    if (threadIdx.x == 0) (void)xb_add(&bar[XB_XCNT(b.x)], 1u);
    return b;
}
__device__ __forceinline__ void xcd_barrier_complete(unsigned* bar, unsigned x, unsigned& nloc, unsigned& nx) {
    const unsigned G = gridDim.x * gridDim.y * gridDim.z;
    unsigned sum, cnt, mine, sp = 0u;
    for (;;) {
        sum = 0u; cnt = 0u; mine = 0u;
#pragma unroll
        for (unsigned j = 0; j < 16; ++j) { const unsigned c = xb_ld(&bar[XB_XCNT(j)]); sum += c; cnt += (c > 0u) ? 1u : 0u; mine = (j == x) ? c : mine; }
        if (sum == G) break;
        __builtin_amdgcn_s_sleep(1);
        if ((++sp & 255u) == 0u) { if (xb_ld(&bar[XB_TMO])) break; if (sp > XB_SPIN_CAP) { atomicAdd(&bar[XB_TMO], 1u); break; } }
    }
    nloc = mine > 0u ? mine : 1u; nx = cnt > 0u ? cnt : 1u;
}

__device__ __forceinline__ void xcd_barrier(const XcdBarrier& b) {
    asm volatile("s_waitcnt vmcnt(0)" ::: "memory");
    __syncthreads();
    if (threadIdx.x == 0) {
        unsigned* bar = b.bar;
        __builtin_amdgcn_s_waitcnt(0);
        unsigned nloc = b.st[0], nx = b.st[1];
        if (nloc == 0u) { xcd_barrier_complete(bar, b.x, nloc, nx); b.st[0] = nloc; b.st[1] = nx; }
        const unsigned old = xb_add(&bar[XB_XSUB(b.x)], 1u);
        const unsigned gen = old / nloc;
        if (old + 1u == (gen + 1u) * nloc) {
            __builtin_amdgcn_fence(__ATOMIC_RELEASE, "agent");
            asm volatile("s_waitcnt vmcnt(0)" ::: "memory");
            const unsigned og = xb_add(&bar[XB_TOP], 1u);
            const unsigned tg = og / nx;
            if (og + 1u == (tg + 1u) * nx) xb_add(&bar[XB_TOPGEN], 1u);
            else XB_SPIN(xb_ld(&bar[XB_TOPGEN]) == tg, bar);
            __builtin_amdgcn_fence(__ATOMIC_ACQUIRE, "agent");
            xb_add(&bar[XB_XGEN(b.x)], 1u);
            asm volatile("s_waitcnt vmcnt(0)" ::: "memory");
        } else {
            XB_SPIN(xb_ld(&bar[XB_XGEN(b.x)]) == gen, bar);
            __builtin_amdgcn_fence(__ATOMIC_ACQUIRE, "agent");
            asm volatile("s_waitcnt vmcnt(0)" ::: "memory");
        }
    }
    __syncthreads();
}

struct Args { const float* in[17]; float* out; unsigned char* ws; };

__global__ void __launch_bounds__(NTHREADS, 2) fwd_kernel(Args a) {
    extern __shared__ __attribute__((aligned(16))) unsigned char lds_raw[];
    cg::grid_group grid = cg::this_grid();
    LAS unsigned char* lds = (LAS unsigned char*)lds_raw;
    const int tid = threadIdx.x, lane = tid & 63, wave = __builtin_amdgcn_readfirstlane(tid >> 6);
    const int G = gridDim.x, gw = blockIdx.x * 8 + wave, NGW = G * 8;
    const size_t gtid = (size_t)blockIdx.x * NTHREADS + tid, gthreads = (size_t)G * NTHREADS;
    unsigned char* ws = a.ws; float* out = a.out;
    volatile LAS unsigned* bst = (volatile LAS unsigned*)(lds + 131072);
    if (tid == 0) { bst[0] = 0u; bst[1] = 0u; }
    __syncthreads();
    XcdBarrier xbar = xcd_barrier_post((unsigned*)(ws + WS_BAR), bst);
    if (a.ws == nullptr) grid.sync();
    {
        LAS float* scr = (LAS float*)(lds + wave * 8448);
        constexpr int I_IN = (DM / 64) * (INW / 32);
        for (int it = gw; it < I_IN; it += NGW) transpose_item(a.in[6], DM, INW, WIN, scr, it, lane);
        for (int m = gw; m < NP + NS; m += NGW) {
            const float* xr = m < NP ? a.in[0] + (size_t)m * DM : a.in[1] + (size_t)(m - NP) * DM;
            rms_row_bf16(xr, a.in[13], H + (size_t)m * DM, lane);
        }
        for (size_t i = gtid; i < (size_t)2 * MPAD; i += gthreads) SS[i] = 0.f;
    }
    xcd_barrier(xbar);

    {
        const int sb = ((int)blockIdx.x + G - (G >> 1)) % G;
        for (int tile = sb; tile < INW / 32; tile += (G >> 1)) {
            if (sb >= (G >> 1)) break;
            float r0, r1; skinny_tile<DM>(H + (size_t)NP * DM, DM, WIN, tile * 32, (LAS float*)lds, wave, lane, r0, r1);
            const int b = tid >> 4, col = tile * 32 + 2 * (tid & 15);
            if (col < 4608) {
                const int which = col / 1536, cin = col - which * 1536, g = cin >> 9, h = (cin >> 6) & 7, d = cin & 63;
                *(unsigned*)(Qb + (size_t)which * (QKV_SZ / 2) + ((size_t)(g * 8 + h) * RQ + NP + b) * 64 + d) = pk_bf16(r0, r1);
                if (which) {
                    const int L = 128 << (2 * g); const size_t ob = g == 0 ? O_KV128S : (g == 1 ? O_KV512S : O_KV2048S);
                    float* o = out + ob + (((size_t)b * L + (L - 1)) * 2 + (which - 1)) * 512 + h * 64 + d;
                    o[0] = r0; o[1] = r1;
                }
            } else {
                *(unsigned*)(PC + (size_t)(NP + b) * PCW + (col - 4608)) = pk_bf16(r0, r1);
            }
        }
        pg8::Gemm g{H, WIN, NP, INW, DM}; CopyOrder S; S.init(NP, INW, G, (int)blockIdx.x);
        S.s0 = (const f32x4*)a.in[2]; S.s1 = (const f32x4*)a.in[3]; S.s2 = (const f32x4*)a.in[4];
        S.d0 = (f32x4*)(out + O_KV128S); S.d1 = (f32x4*)(out + O_KV512S); S.d2 = (f32x4*)(out + O_KV2048S); S.ui = 0;
        EpiIn E{Qb, PC};
        pg8::gemm_phase<EpiIn, CopyOrder, true, true>(lds, g, S, E);
        if ((int)blockIdx.x >= (G >> 1)) {
            const int tid = threadIdx.x, lane = tid & 63, wave = __builtin_amdgcn_readfirstlane(tid >> 6);
            LAS float* scr = (LAS float*)(lds + wave * 8448);
            constexpr int I_AO = (512 / 64) * (DM / 32), I_CO = (DM / 64) * (DM / 32), I_O = I_CO, I_F1 = (DM / 64) * (DFF / 32), I_F2 = (DFF / 64) * (DM / 32);
            constexpr int NIT = I_AO + I_CO + I_O + I_F1 + I_F2;
            const int hw = ((int)blockIdx.x - (G >> 1)) * 8 + wave, HW = (G - (G >> 1)) * 8;
            for (int it = hw; it < NIT; it += HW) {
                int r = it;
                if (r < I_AO) { transpose_item(a.in[8], 512, DM, WAO, scr, r, lane); continue; } r -= I_AO;
                if (r < I_CO) { transpose_item(a.in[9], DM, DM, WCO, scr, r, lane); continue; } r -= I_CO;
                if (r < I_O) { transpose_item(a.in[10], DM, DM, WO, scr, r, lane); continue; } r -= I_O;
                if (r < I_F1) { transpose_item(a.in[11], DM, DFF, WF1, scr, r, lane); continue; } r -= I_F1;
                transpose_item(a.in[12], DFF, DM, WF2, scr, r, lane);
            }
            const size_t ht = (size_t)((int)blockIdx.x - (G >> 1)) * NTHREADS + tid, HT = (size_t)(G - (G >> 1)) * NTHREADS;
            const f32x4* s2 = (const f32x4*)a.in[4]; f32x4* d2 = (f32x4*)(out + O_KV2048S);
#pragma unroll 4
            for (size_t f = CPY_HOOK + ht; f < CPY_TOT; f += HT) {
                const size_t r = f - CPY_T1;
                if ((r & (2048 * 256 - 1)) < 2047 * 256) { const f32x4 v = __builtin_nontemporal_load(s2 + r + 256); __builtin_nontemporal_store(v, d2 + r); }
            }
        }
    }
    xcd_barrier(xbar);

    {
        LAS unsigned char* wl = lds + wave * 8704;
        for (int t = gw; t < 3 * 8 * 512; t += NGW) attn_prompt_task(t, Qb, Kb, Vb, OG, LSE, wl, lane);
#if REP_P2 == 2
        for (int t = gw; t < 3 * 8 * 512; t += NGW) attn_prompt_task(t, Qb, Kb, Vb, OG, LSE, wl, lane);
#endif
        for (int t = NGW - 1 - gw; t < 768; t += NGW) attn_sample_task(t, Qb, Kb, Vb, a.in[2], a.in[3], a.in[4], (float*)(ws + WS_SO), (float*)(ws + WS_SO) + 768 * 64, (LAS float*)wl, lane);
        for (int t = gw; t < 2048; t += NGW) conv_prompt_task(t, PC, a.in[7], CV, out, lane);
        for (size_t i = gtid; i < 32 * 128; i += gthreads) {
            const int b = (int)(i >> 7), col = (int)(i & 127) * 8; const size_t row = (size_t)(NP + b);
            float cc[8], ch[8], cb[8], o[8];
            unpack8(*(const u32x4*)(PC + row * PCW + 1024 + col), cc); unpack8(*(const u32x4*)(PC + row * PCW + 2048 + col), ch); unpack8(*(const u32x4*)(PC + row * PCW + col), cb);
            const float* st = a.in[5] + (size_t)b * 2048 + col; const float* cw = a.in[7] + col;
            float* oc = out + O_CONVS + (size_t)b * 2048 + col;
#pragma unroll
            for (int j = 0; j < 8; ++j) {
                const float u = cc[j] * ch[j], s0 = st[j], s1 = st[1024 + j];
                o[j] = cb[j] * (cw[j] * s0 + cw[1024 + j] * s1 + cw[2048 + j] * u);
                oc[j] = s1; oc[1024 + j] = u;
            }
            *(u32x4*)(CV + row * DM + col) = pack8(o);
        }
#pragma unroll
        for (int g = 0; g < 3; ++g) {
            const int sh = 2 * g, W = 128 << sh; float* dst = out + (g == 0 ? O_KV128P : (g == 1 ? O_KV512P : O_KV2048P));
            for (size_t i = gtid; i < (size_t)256 * W; i += gthreads) {
                const int d8 = (int)(i & 7), h = (int)(i >> 3) & 7, kv = (int)(i >> 6) & 1; const int br = (int)(i >> 7), r = br & (W - 1), b = br >> (7 + sh);
                const int t = 8192 - W + r, rowp = (b << 13) | ((t & ((1 << sh) - 1)) << (13 - sh)) | (t >> sh);
                float f[8]; unpack8(*(const u32x4*)((kv ? Vb : Kb) + ((size_t)(g * 8 + h) * RQ + rowp) * 64 + d8 * 8), f);
                float* o = dst + i * 8;
                *(f32x4*)o = (f32x4){f[0], f[1], f[2], f[3]}; *(f32x4*)(o + 4) = (f32x4){f[4], f[5], f[6], f[7]};
            }
        }
    }
    xcd_barrier(xbar);

    for (size_t i = gtid; i < (size_t)NP * 64; i += gthreads) {
        const size_t row = i >> 6; const int hd = (int)(i & 63), h = hd >> 3;
        const float L0 = LSE[row * 8 + h], L1 = LSE[((size_t)NP + row) * 8 + h], L2 = LSE[((size_t)2 * NP + row) * 8 + h];
        const float M = fmaxf(fmaxf(L0, L1), L2);
        float w0 = exp2f(L0 - M), w1 = exp2f(L1 - M), w2 = exp2f(L2 - M); const float inv = 1.f / (w0 + w1 + w2); w0 *= inv; w1 *= inv; w2 *= inv;
        float x0[8], x1[8], x2[8], o[8];
        unpack8(*(const u32x4*)(OG + row * 512 + hd * 8), x0); unpack8(*(const u32x4*)(OG + ((size_t)NP + row) * 512 + hd * 8), x1); unpack8(*(const u32x4*)(OG + ((size_t)2 * NP + row) * 512 + hd * 8), x2);
#pragma unroll
        for (int j = 0; j < 8; ++j) o[j] = w0 * x0[j] + w1 * x1[j] + w2 * x2[j];
        *(u32x4*)(ATTN + row * 512 + hd * 8) = pack8(o);
    }
    {
        const float* SO = (const float*)(ws + WS_SO); const float* SL = SO + 768 * 64;
        for (size_t i = gtid; i < (size_t)NS * 8 * 64; i += gthreads) {
            const int bh = (int)(i >> 6), d = (int)(i & 63);
            const float L0 = SL[bh], L1 = SL[256 + bh], L2 = SL[512 + bh];
            const float M = fmaxf(fmaxf(L0, L1), L2);
            const float w0 = exp2f(L0 - M), w1 = exp2f(L1 - M), w2 = exp2f(L2 - M);
            const float o = (w0 * SO[(size_t)bh * 64 + d] + w1 * SO[(size_t)(256 + bh) * 64 + d] + w2 * SO[(size_t)(512 + bh) * 64 + d]) / (w0 + w1 + w2);
            ATTN[(size_t)(NP + (bh >> 3)) * 512 + (bh & 7) * 64 + d] = (bf16_t)(pk_bf16(o, 0.f) & 0xffffu);
        }
    }
    xcd_barrier(xbar);

    {
        if ((int)blockIdx.x < DM / 32) {
            const int n0 = (int)blockIdx.x * 32; float a0, a1, c0, c1;
            skinny_tile<512>(ATTN + (size_t)NP * 512, 512, WAO, n0, (LAS float*)lds, wave, lane, a0, a1);
            skinny_tile<DM>(CV + (size_t)NP * DM, DM, WCO, n0, (LAS float*)lds, wave, lane, c0, c1);
            const int b = tid >> 4, col = n0 + 2 * (tid & 15);
            const unsigned ga = *(const unsigned*)(PC + (size_t)(NP + b) * PCW + 3072 + col), gc = *(const unsigned*)(PC + (size_t)(NP + b) * PCW + 4096 + col);
            *(unsigned*)(MIXIN + (size_t)(NP + b) * DM + col) = pk_bf16(sigm(bf_lo(ga)) * a0 + sigm(bf_lo(gc)) * c0, sigm(bf_hi(ga)) * a1 + sigm(bf_hi(gc)) * c1);
        }
        pg8::StaticOrder S; S.init(NP, DM, G, (int)blockIdx.x);
        { pg8::Gemm g{ATTN, WAO, NP, DM, 512}; EpiGateA E{PC, T}; pg8::gemm_phase<EpiGateA, pg8::StaticOrder, true, true>(lds, g, S, E); }
        { pg8::Gemm g{CV, WCO, NP, DM, DM}; EpiGateC E{PC, T, MIXIN}; pg8::gemm_phase<EpiGateC, pg8::StaticOrder, true, true>(lds, g, S, E); }
    }
    xcd_barrier(xbar);

    {
        if ((int)blockIdx.x < DM / 32) {
            const int n0 = (int)blockIdx.x * 32; float r0, r1;
            skinny_tile<DM>(MIXIN + (size_t)NP * DM, DM, WO, n0, (LAS float*)lds, wave, lane, r0, r1);
            const int b = tid >> 4, col = n0 + 2 * (tid & 15);
            *(unsigned*)(MIX + (size_t)(NP + b) * DM + col) = pk_bf16(r0, r1);
            float sq = r0 * r0 + r1 * r1; sq += __shfl_xor(sq, 1); sq += __shfl_xor(sq, 2); sq += __shfl_xor(sq, 4); sq += __shfl_xor(sq, 8);
            if ((tid & 15) == 0) atomicAdd(SS + NP + b, sq);
        }
        pg8::Gemm g{MIXIN, WO, NP, DM, DM}; pg8::StaticOrder S; S.init(NP, DM, G, (int)blockIdx.x);
        EpiSS E{MIX, SS};
        pg8::gemm_phase<EpiSS, pg8::StaticOrder, true, true>(lds, g, S, E);
    }
    xcd_barrier(xbar);

    for (int m = gw; m < NP + NS; m += NGW) {
        const float* xr = m < NP ? a.in[0] + (size_t)m * DM : a.in[1] + (size_t)(m - NP) * DM;
        norm1_row(xr, MIX + (size_t)m * DM, SS[m], a.in[14], a.in[15], X1 + (size_t)m * DM, H2 + (size_t)m * DM, lane);
    }
    xcd_barrier(xbar);

    {
        if ((int)blockIdx.x < DFF / 32) {
            const int n0 = (int)blockIdx.x * 32; float r0, r1;
            skinny_tile<DM>(H2 + (size_t)NP * DM, DM, WF1, n0, (LAS float*)lds, wave, lane, r0, r1);
            const int b = tid >> 4, col = n0 + 2 * (tid & 15);
            r0 = fmaxf(r0, 0.f); r1 = fmaxf(r1, 0.f);
            *(unsigned*)(HID + (size_t)(NP + b) * DFF + col) = pk_bf16(r0 * r0, r1 * r1);
        }
        pg8::Gemm g{H2, WF1, NP, DFF, DM}; pg8::StaticOrder S; S.init(NP, DFF, G, (int)blockIdx.x);
        EpiRelu2 E{HID};
        pg8::gemm_phase<EpiRelu2, pg8::StaticOrder, true, true>(lds, g, S, E);
    }
    xcd_barrier(xbar);

    {
        if ((int)blockIdx.x < DM / 32) {
            const int n0 = (int)blockIdx.x * 32; float r0, r1;
            skinny_tile<DFF>(HID + (size_t)NP * DFF, DFF, WF2, n0, (LAS float*)lds, wave, lane, r0, r1);
            const int b = tid >> 4, col = n0 + 2 * (tid & 15);
            *(unsigned*)(Fb + (size_t)(NP + b) * DM + col) = pk_bf16(r0, r1);
            float sq = r0 * r0 + r1 * r1; sq += __shfl_xor(sq, 1); sq += __shfl_xor(sq, 2); sq += __shfl_xor(sq, 4); sq += __shfl_xor(sq, 8);
            if ((tid & 15) == 0) atomicAdd(SS + MPAD + NP + b, sq);
        }
        pg8::Gemm g{HID, WF2, NP, DM, DFF}; pg8::StaticOrder S; S.init(NP, DM, G, (int)blockIdx.x);
        EpiSS E{Fb, SS + MPAD};
        pg8::gemm_phase<EpiSS, pg8::StaticOrder, true, true>(lds, g, S, E);
    }
    xcd_barrier(xbar);

    for (int m = gw; m < NP + NS; m += NGW) {
        float* yr = m < NP ? out + O_YP + (size_t)m * DM : out + O_YS + (size_t)(m - NP) * DM;
        norm2_row(yr, X1 + (size_t)m * DM, Fb + (size_t)m * DM, SS[MPAD + m], a.in[16], lane);
    }
}

extern "C" void kernel_launch(void* const* d_in, const int* in_sizes, int n_in, void* d_out, int out_size, void* d_ws, size_t ws_size, hipStream_t stream) {
    static int grid_blocks = 0;
    if (grid_blocks == 0) {
        if (n_in != 17 || ws_size < WS_END) { fprintf(stderr, "kernel_launch: unexpected n_in %d or ws_size %zu (< %zu)\n", n_in, ws_size, (size_t)WS_END); grid_blocks = -1; return; }
        int dev = 0, cus = 0, per_cu = 0;
        hipGetDevice(&dev);
        hipDeviceGetAttribute(&cus, hipDeviceAttributeMultiprocessorCount, dev);
        if (hipFuncSetAttribute((const void*)fwd_kernel, hipFuncAttributeMaxDynamicSharedMemorySize, LDS_BYTES) != hipSuccess) { fprintf(stderr, "kernel_launch: hipFuncSetAttribute failed\n"); grid_blocks = -1; return; }
        if (hipOccupancyMaxActiveBlocksPerMultiprocessor(&per_cu, (const void*)fwd_kernel, NTHREADS, LDS_BYTES) != hipSuccess || per_cu < 1) { fprintf(stderr, "kernel_launch: occupancy query failed (%d)\n", per_cu); per_cu = 1; (void)hipGetLastError(); }
        if (per_cu > 1) per_cu = 1;
        grid_blocks = cus * per_cu;
    }
    if (grid_blocks < 0) return;
    if (hipMemsetAsync((char*)d_ws + WS_BAR, 0, 16384, stream) != hipSuccess) { fprintf(stderr, "kernel_launch: memset failed\n"); return; }
    Args a{};
    for (int i = 0; i < 17; ++i) a.in[i] = (const float*)d_in[i];
    a.out = (float*)d_out; a.ws = (unsigned char*)d_ws;
    void* args[] = {&a};
    hipError_t e = hipLaunchCooperativeKernel((const void*)fwd_kernel, dim3(grid_blocks), dim3(NTHREADS), args, LDS_BYTES, stream);
    if (e != hipSuccess) fprintf(stderr, "cooperative launch failed: %s (grid %d)\n", hipGetErrorString(e), grid_blocks);
}
```

```cpp
#include <hip/hip_runtime.h>
#include <hip/hip_cooperative_groups.h>
#include <cstdio>
#include <cstdint>
namespace cg = cooperative_groups;
namespace pg8 {
#define PG8_LAS __attribute__((address_space(3)))
typedef unsigned short bf16_t;
typedef short bf16x8 __attribute__((ext_vector_type(8)));
typedef float f32x4 __attribute__((ext_vector_type(4)));
typedef unsigned u32x4 __attribute__((ext_vector_type(4)));
constexpr int BM = 256, BK = 64, HALF = 128, HTB = HALF * BK * 2  , STAGE_BYTES = 8 * HTB, NXCD = 8, WGM = 8;

__host__ __device__ __forceinline__ int lds_byte(int r, int c) { const int st = (r >> 4) * 2 + (c >> 5), rr = r & 15, cc = c & 31, ob = rr * 64 + cc * 2; return st * 1024 + (ob ^ (((ob >> 9) & 1) << 5)); }
__host__ __device__ __forceinline__ void stage_rc(int b, int& R, int& C) { const int st = b / 1024, sb = b % 1024, swz = sb ^ (((sb >> 9) & 1) << 5); R = (st >> 1) * 16 + swz / 64; C = (st & 1) * 32 + (swz % 64) / 2; }
__host__ __device__ __forceinline__ int perm32(int rho) { const int n = rho >> 4, i = rho & 15; return 8 * (i >> 2) + 4 * n + (i & 3); }

struct Unit { int pm, pn; };
struct Gemm { const bf16_t* A; const bf16_t* Bt; int M, N, K; };

struct StaticOrder {
    int nM, nN, nwg, G, c;
    __host__ __device__ void init(int M, int N, int G_, int c_) { nM = M / BM; nN = N / BM; nwg = nM * nN; G = G_; c = c_; }
    __host__ __device__ bool next(int i, Unit& u) const {
        const long L = (long)i * G + c; if (L >= nwg) return false;
        int wgid = (int)L; { const int q = nwg / NXCD, r = nwg % NXCD, xcd = wgid % NXCD, off = wgid / NXCD; wgid = (xcd < r ? xcd * (q + 1) : r * (q + 1) + (xcd - r) * q) + off; }
        const int nig = WGM * nN, gid = wgid / nig, fm = gid * WGM, gsz = (nM - fm) < WGM ? (nM - fm) : WGM;
        u.pm = fm + ((wgid % nig) % gsz); u.pn = (wgid % nig) / gsz; return true;
    }
    __device__ __forceinline__ void a_ready(const Unit&) const {}
    __device__ __forceinline__ void done(const Unit&) const {}
};
__device__ __forceinline__ unsigned cvt_pk_bf16(float lo, float hi) { unsigned r; asm volatile("v_cvt_pk_bf16_f32 %0, %1, %2" : "=v"(r) : "v"(lo), "v"(hi)); return r; }
template <class Epi, class Sched, bool ALIGN_EPI = false, bool SP2 = false>
__device__ __forceinline__ void gemm_phase(PG8_LAS unsigned char* lds, const Gemm g, const Sched& S, const Epi& E) {
    int tid_ = threadIdx.x; asm volatile("" : "+v"(tid_));
    const int tid = tid_, wid = __builtin_amdgcn_readfirstlane(tid >> 6), lane = tid & 63, wr = wid >> 2, wc = wid & 3, fr = lane & 15, fq = lane >> 4;
    const int K = g.K, nt = K / BK;
    unsigned voffA[2], voffB[2];
#pragma unroll
    for (int i = 0; i < 2; ++i) { int R, C; stage_rc(tid * 16 + i * 8192, R, C); const int Rb = Epi::PERM ? ((R & ~31) + perm32(R & 31)) : R;
        voffA[i] = (unsigned)(R * K + C) * 2u; voffB[i] = (unsigned)(Rb * K + C) * 2u; }
    const size_t kstep = (size_t)(BK * 2);
    const size_t hstep = (size_t)HALF * K * 2;
    const size_t tstep = 2 * hstep;
    const unsigned ldsw = (unsigned)wid * 1024u;
    const int aoff = lds_byte(wr * 64 + fr, fq * 8), boff = lds_byte(wc * 32 + fr, fq * 8);
#define PG8_SA(b, h) (((b) * 2 + (h)) * HTB)
#define PG8_SB(b, h) ((4 + (b) * 2 + (h)) * HTB)
#define PG8_STAGE(bufoff, gbase, voff) do { _Pragma("unroll") for (int _i = 0; _i < 2; ++_i) \
        __builtin_amdgcn_global_load_lds((const unsigned*)((const char*)(gbase) + (voff)[_i]), (PG8_LAS unsigned*)(lds + (bufoff) + ldsw + _i * 8192), 16, 0, 0); } while (0)
#define PG8_LDA(dst, b, h) do { _Pragma("unroll") for (int m = 0; m < 4; ++m) _Pragma("unroll") for (int k = 0; k < 2; ++k) dst[m][k] = *(const PG8_LAS bf16x8*)(lds + PG8_SA(b, h) + aoff + m * 2048 + k * 1024); } while (0)
#define PG8_LDB(dst, b, h) do { _Pragma("unroll") for (int n = 0; n < 2; ++n) _Pragma("unroll") for (int k = 0; k < 2; ++k) dst[n][k] = *(const PG8_LAS bf16x8*)(lds + PG8_SB(b, h) + boff + n * 2048 + k * 1024); } while (0)
#define PG8_MMA(ai, bj, At, Bt) do { __builtin_amdgcn_s_setprio(1); _Pragma("unroll") for (int m = 0; m < 4; ++m) _Pragma("unroll") for (int n = 0; n < 2; ++n) _Pragma("unroll") for (int k = 0; k < 2; ++k) \
        acc[ai][bj][m][n] = __builtin_amdgcn_mfma_f32_16x16x32_bf16(Bt[n][k], At[m][k], acc[ai][bj][m][n], 0, 0, 0); __builtin_amdgcn_s_setprio(0); } while (0)
#define PG8_WAIT_V(n) asm volatile("s_waitcnt vmcnt(" #n ")" ::: "memory")
#define PG8_WAIT_L(n) asm volatile("s_waitcnt lgkmcnt(" #n ")" ::: "memory")
#define PG8_BAR __builtin_amdgcn_s_barrier()
#define PG8_SCHED __builtin_amdgcn_sched_barrier(0)
    Unit cur, nxt; int ui = 0;
    if (!S.next(0, cur)) return;
    f32x4 acc[2][2][4][2];
#pragma unroll
    for (int a = 0; a < 2; ++a)
#pragma unroll
        for (int b = 0; b < 2; ++b)
#pragma unroll
            for (int m = 0; m < 4; ++m)
#pragma unroll
                for (int n = 0; n < 2; ++n) acc[a][b][m][n] = (f32x4){0.f, 0.f, 0.f, 0.f};
    bf16x8 At[4][2], B0[2][2], B1[2][2];
    const char* cA = (const char*)g.A + (size_t)cur.pm * tstep; const char* cB = (const char*)g.Bt + (size_t)cur.pn * tstep;
    S.a_ready(cur);
    if constexpr (SP2) {
        PG8_STAGE(PG8_SB(0, 0), cB, voffB); PG8_STAGE(PG8_SB(0, 1), cB + hstep, voffB); PG8_STAGE(PG8_SA(0, 0), cA, voffA); PG8_STAGE(PG8_SA(0, 1), cA + hstep, voffA);
        if (wr == 1) PG8_BAR;
        PG8_WAIT_V(2); PG8_BAR;
        PG8_STAGE(PG8_SB(1, 0), cB + kstep, voffB); PG8_STAGE(PG8_SA(1, 0), cA + kstep, voffA); PG8_STAGE(PG8_SB(1, 1), cB + hstep + kstep, voffB);
        PG8_WAIT_V(6); PG8_BAR;
    } else {
        PG8_STAGE(PG8_SB(0, 0), cB, voffB); PG8_STAGE(PG8_SA(0, 0), cA, voffA); PG8_STAGE(PG8_SB(0, 1), cB + hstep, voffB); PG8_STAGE(PG8_SA(0, 1), cA + hstep, voffA);
        if (wr == 1) PG8_BAR;
        PG8_WAIT_V(4); PG8_BAR;
        PG8_STAGE(PG8_SB(1, 0), cB + kstep, voffB); PG8_STAGE(PG8_SA(1, 0), cA + kstep, voffA); PG8_STAGE(PG8_SB(1, 1), cB + hstep + kstep, voffB);
        PG8_WAIT_V(6); PG8_BAR;
    }
    for (;;) {
        const bool has_next = S.next(ui + 1, nxt);
        const char* nA = has_next ? (const char*)g.A + (size_t)nxt.pm * tstep : cA; const char* nB = has_next ? (const char*)g.Bt + (size_t)nxt.pn * tstep : cB;
        for (int t = 0; t < nt; t += 2) {
            const bool last = (t == nt - 2);
            const char* a1 = cA + (size_t)(t + 1) * kstep;
            const char* a2 = last ? nA : cA + (size_t)(t + 2) * kstep; const char* b2 = last ? nB : cB + (size_t)(t + 2) * kstep;
            const char* a3 = a2 + kstep; const char* b3 = b2 + kstep;
            if (last && has_next) S.a_ready(nxt);
            if constexpr (SP2) {
            PG8_LDB(B0, 0, 0); PG8_LDB(B1, 0, 1); PG8_SCHED; PG8_LDA(At, 0, 0); PG8_STAGE(PG8_SA(1, 1), a1 + hstep, voffA);
            PG8_WAIT_V(8); PG8_WAIT_L(0); PG8_BAR; PG8_MMA(0, 0, At, B0); PG8_MMA(0, 1, At, B1); PG8_BAR; PG8_SCHED;
            PG8_LDA(At, 0, 1); PG8_STAGE(PG8_SB(0, 0), b2, voffB); PG8_STAGE(PG8_SB(0, 1), b2 + hstep, voffB); PG8_STAGE(PG8_SA(0, 0), a2, voffA);
            PG8_WAIT_V(8); PG8_WAIT_L(0); PG8_BAR; PG8_MMA(1, 0, At, B0); PG8_MMA(1, 1, At, B1); PG8_BAR; PG8_SCHED;
            PG8_LDB(B0, 1, 0); PG8_LDB(B1, 1, 1); PG8_SCHED; PG8_LDA(At, 1, 0); PG8_STAGE(PG8_SA(0, 1), a2 + hstep, voffA);
            PG8_WAIT_V(8); PG8_WAIT_L(0); PG8_BAR; PG8_MMA(0, 0, At, B0); PG8_MMA(0, 1, At, B1); PG8_BAR; PG8_SCHED;
            PG8_LDA(At, 1, 1); PG8_STAGE(PG8_SB(1, 0), b3, voffB); PG8_STAGE(PG8_SB(1, 1), b3 + hstep, voffB); PG8_STAGE(PG8_SA(1, 0), a3, voffA);
            PG8_WAIT_V(8); PG8_WAIT_L(0); PG8_BAR; PG8_MMA(1, 0, At, B0); PG8_MMA(1, 1, At, B1); PG8_BAR; PG8_SCHED;
            } else {
            PG8_LDB(B0, 0, 0); PG8_SCHED; PG8_LDA(At, 0, 0); PG8_STAGE(PG8_SA(1, 1), a1 + hstep, voffA);
            PG8_WAIT_L(8); PG8_BAR; PG8_WAIT_L(0); PG8_MMA(0, 0, At, B0); PG8_BAR; PG8_SCHED;
            PG8_LDB(B1, 0, 1); PG8_STAGE(PG8_SB(0, 0), b2, voffB);
            PG8_BAR; PG8_WAIT_L(0); PG8_MMA(0, 1, At, B1); PG8_BAR;
            PG8_LDA(At, 0, 1); PG8_STAGE(PG8_SA(0, 0), a2, voffA);
            PG8_BAR; PG8_WAIT_L(0); PG8_MMA(1, 0, At, B0); PG8_BAR; PG8_SCHED;
            PG8_STAGE(PG8_SB(0, 1), b2 + hstep, voffB);
            PG8_WAIT_V(6); PG8_BAR; PG8_MMA(1, 1, At, B1); PG8_BAR;
            PG8_LDB(B0, 1, 0); PG8_SCHED; PG8_LDA(At, 1, 0); PG8_STAGE(PG8_SA(0, 1), a2 + hstep, voffA);
            PG8_WAIT_L(8); PG8_BAR; PG8_WAIT_L(0); PG8_MMA(0, 0, At, B0); PG8_BAR; PG8_SCHED;
            PG8_LDB(B1, 1, 1); PG8_STAGE(PG8_SB(1, 0), b3, voffB);
            PG8_BAR; PG8_WAIT_L(0); PG8_MMA(0, 1, At, B1); PG8_BAR;
            PG8_LDA(At, 1, 1); PG8_STAGE(PG8_SA(1, 0), a3, voffA);
            PG8_BAR; PG8_WAIT_L(0); PG8_MMA(1, 0, At, B0); PG8_BAR; PG8_SCHED;
            PG8_STAGE(PG8_SB(1, 1), b3 + hstep, voffB);
            PG8_WAIT_V(6); PG8_BAR; PG8_MMA(1, 1, At, B1); PG8_BAR;
            }
        }
        if constexpr (ALIGN_EPI) { if (wr == 0) PG8_BAR; }
        if constexpr (!Epi::AFTER_DRAIN) { E(acc, cur, wr, wc, fr, fq); S.done(cur); }
        if (!has_next) break;
#pragma unroll
        for (int a = 0; a < 2; ++a)
#pragma unroll
            for (int b = 0; b < 2; ++b)
#pragma unroll
                for (int m = 0; m < 4; ++m)
#pragma unroll
                    for (int n = 0; n < 2; ++n) acc[a][b][m][n] = (f32x4){0.f, 0.f, 0.f, 0.f};
        cur = nxt; cA = nA; cB = nB; ++ui;
        if constexpr (ALIGN_EPI) { if (wr == 1) PG8_BAR; }
    }
    PG8_WAIT_V(0);
    if constexpr (!ALIGN_EPI) { if (wr == 0) PG8_BAR; }
    PG8_BAR;
    if constexpr (Epi::AFTER_DRAIN) { E.fused(acc, cur, wr, wc, fr, fq, lds, wid, lane); S.done(cur); }
#undef PG8_SA
#undef PG8_SB
#undef PG8_STAGE
#undef PG8_LDA
#undef PG8_LDB
#undef PG8_MMA
#undef PG8_WAIT_V
#undef PG8_WAIT_L
#undef PG8_BAR
#undef PG8_SCHED
}
}

#define LAS __attribute__((address_space(3)))
typedef unsigned short bf16_t;
typedef float f32x4 __attribute__((ext_vector_type(4)));
typedef float f32x16 __attribute__((ext_vector_type(16)));
typedef unsigned u32x4 __attribute__((ext_vector_type(4)));
typedef unsigned u32x2 __attribute__((ext_vector_type(2)));
typedef short bf16x8 __attribute__((ext_vector_type(8)));
typedef short s16x4 __attribute__((ext_vector_type(4)));

constexpr int NP = 16384, NS = 32, MPAD = 16640, DM = 1024, INW = 9728, DFF = 4096, RQ = 16640, PCW = 5120;
constexpr float EPS = 1e-6f;
constexpr float C2 = 0.125f * 1.4426950408889634f;
constexpr int LDS_BYTES = 131072 + 256;
constexpr int NTHREADS = 512;

constexpr size_t O_YP = 0, O_YS = 16777216, O_KV128P = 16809984, O_KV512P = 17072128, O_KV2048P = 18120704, O_CONVP = 22315008,
                 O_KV128S = 22319104, O_KV512S = 26513408, O_KV2048S = 43290624, O_CONVS = 110399488;

constexpr size_t WS_WIN = 0;
constexpr size_t WS_WAO = WS_WIN + (size_t)INW * DM * 2;
constexpr size_t WS_WCO = WS_WAO + (size_t)DM * 512 * 2;
constexpr size_t WS_WO = WS_WCO + (size_t)DM * DM * 2;
constexpr size_t WS_WF1 = WS_WO + (size_t)DM * DM * 2;
constexpr size_t WS_WF2 = WS_WF1 + (size_t)DFF * DM * 2;
constexpr size_t WS_H = WS_WF2 + (size_t)DFF * DM * 2;
constexpr size_t QKV_SZ = (size_t)24 * RQ * 64 * 2;
constexpr size_t WS_Q = WS_H + (size_t)MPAD * DM * 2;
constexpr size_t WS_K = WS_Q + QKV_SZ, WS_V = WS_K + QKV_SZ;
constexpr size_t WS_HID = WS_Q;
constexpr size_t WS_PC = WS_V + QKV_SZ;
constexpr size_t WS_OG = WS_PC + (size_t)MPAD * PCW * 2;
constexpr size_t WS_LSE = WS_OG + (size_t)3 * NP * 512 * 2;
constexpr size_t WS_ATTN = WS_LSE + (size_t)3 * NP * 8 * 4;
constexpr size_t WS_CV = WS_ATTN + (size_t)MPAD * 512 * 2;
constexpr size_t WS_T = WS_CV + (size_t)MPAD * DM * 2;
constexpr size_t WS_MIXIN = WS_T + (size_t)MPAD * DM * 4;
constexpr size_t WS_MIX = WS_MIXIN + (size_t)MPAD * DM * 2;
constexpr size_t WS_H2 = WS_MIX + (size_t)MPAD * DM * 2;
constexpr size_t WS_F = WS_H2 + (size_t)MPAD * DM * 2;
constexpr size_t WS_SS = WS_F + (size_t)MPAD * DM * 2;
constexpr size_t WS_BAR = WS_SS + (size_t)2 * MPAD * 4;
constexpr size_t WS_SO = WS_BAR + 16384;
constexpr size_t WS_END = WS_SO + (size_t)(768 * 64 + 768) * 4;
static_assert((size_t)MPAD * DFF * 2 <= 3 * QKV_SZ, "hid overlay");

__device__ __forceinline__ unsigned pk_bf16(float lo, float hi) { return pg8::cvt_pk_bf16(lo, hi); }
__device__ __forceinline__ float bf_lo(unsigned w) { return __uint_as_float(w << 16); }
__device__ __forceinline__ float bf_hi(unsigned w) { return __uint_as_float(w & 0xffff0000u); }
__device__ __forceinline__ float bf2f(bf16_t v) { return __uint_as_float((unsigned)v << 16); }
__device__ __forceinline__ float sigm(float x) { return 1.f / (1.f + __expf(-x)); }
__device__ __forceinline__ void unpack8(const u32x4 w, float (&f)[8]) {
    f[0] = bf_lo(w.x); f[1] = bf_hi(w.x); f[2] = bf_lo(w.y); f[3] = bf_hi(w.y); f[4] = bf_lo(w.z); f[5] = bf_hi(w.z); f[6] = bf_lo(w.w); f[7] = bf_hi(w.w);
}
__device__ __forceinline__ u32x4 pack8(const float (&f)[8]) {
    u32x4 w; w.x = pk_bf16(f[0], f[1]); w.y = pk_bf16(f[2], f[3]); w.z = pk_bf16(f[4], f[5]); w.w = pk_bf16(f[6], f[7]); return w;
}
__device__ __forceinline__ float wave_sum(float v) {
#pragma unroll
    for (int o = 1; o < 64; o <<= 1) v += __shfl_xor(v, o);
    return v;
}
__device__ __forceinline__ float wave_max(float v) {
#pragma unroll
    for (int o = 1; o < 64; o <<= 1) v = fmaxf(v, __shfl_xor(v, o));
    return v;
}

struct EpiIn {
    static constexpr bool PERM = true, AFTER_DRAIN = false;
    bf16_t *Q, *PC;
    __device__ __forceinline__ void operator()(const f32x4 (&acc)[2][2][4][2], const pg8::Unit& u, int wr, int wc, int fr, int fq) const {
        const int colt = u.pn * 256, row0 = u.pm * 256 + wr * 64 + fr;
        if (colt < 4608) {
            const int which = colt / 1536, cin = colt - which * 1536;
            bf16_t* base = Q + (size_t)which * (QKV_SZ / 2);
            const int g = cin >> 9, sh = 2 * g;
#pragma unroll
            for (int ai = 0; ai < 2; ++ai)
#pragma unroll
                for (int m = 0; m < 4; ++m) {
                    const int row = row0 + ai * 128 + m * 16;
                    const int rowp = row < NP ? ((row & ~8191) | ((row & ((1 << sh) - 1)) << (13 - sh)) | ((row & 8191) >> sh)) : row;
#pragma unroll
                    for (int bj = 0; bj < 2; ++bj) {
                        const int cgc = cin + bj * 128 + wc * 32 + 8 * fq, h = (cgc >> 6) & 7, d = cgc & 63;
                        const f32x4 v0 = acc[ai][bj][m][0], v1 = acc[ai][bj][m][1];
                        u32x4 w; w.x = pk_bf16(v0[0], v0[1]); w.y = pk_bf16(v0[2], v0[3]); w.z = pk_bf16(v1[0], v1[1]); w.w = pk_bf16(v1[2], v1[3]);
                        *(u32x4*)(base + ((size_t)(g * 8 + h) * RQ + rowp) * 64 + d) = w;
                    }
                }
        } else if (colt >= 5632 && colt < 7680) {
            const int c0 = 1024 + ((colt - 5632) >> 8) * 128 + wc * 32 + 8 * fq;
#pragma unroll
            for (int ai = 0; ai < 2; ++ai)
#pragma unroll
                for (int m = 0; m < 4; ++m) {
                    const f32x4 v0 = acc[ai][0][m][0] * acc[ai][1][m][0], v1 = acc[ai][0][m][1] * acc[ai][1][m][1];
                    u32x4 w; w.x = pk_bf16(v0[0], v0[1]); w.y = pk_bf16(v0[2], v0[3]); w.z = pk_bf16(v1[0], v1[1]); w.w = pk_bf16(v1[2], v1[3]);
                    *(u32x4*)(PC + (size_t)(row0 + ai * 128 + m * 16) * PCW + c0) = w;
                }
        } else {
            const int c0 = colt - 4608 + wc * 32 + 8 * fq;
#pragma unroll
            for (int ai = 0; ai < 2; ++ai)
#pragma unroll
                for (int m = 0; m < 4; ++m) {
                    bf16_t* rowp = PC + (size_t)(row0 + ai * 128 + m * 16) * PCW + c0;
#pragma unroll
                    for (int bj = 0; bj < 2; ++bj) {
                        const f32x4 v0 = acc[ai][bj][m][0], v1 = acc[ai][bj][m][1];
                        u32x4 w; w.x = pk_bf16(v0[0], v0[1]); w.y = pk_bf16(v0[2], v0[3]); w.z = pk_bf16(v1[0], v1[1]); w.w = pk_bf16(v1[2], v1[3]);
                        *(u32x4*)(rowp + bj * 128) = w;
                    }
                }
        }
    }
};

struct EpiGateA {
    static constexpr bool PERM = true, AFTER_DRAIN = false;
    const bf16_t* PC; bf16_t* T;
    __device__ __forceinline__ void operator()(const f32x4 (&acc)[2][2][4][2], const pg8::Unit& u, int wr, int wc, int fr, int fq) const {
        const int row0 = u.pm * 256 + wr * 64 + fr, col0 = u.pn * 256 + wc * 32 + 8 * fq;
#pragma unroll
        for (int ai = 0; ai < 2; ++ai)
#pragma unroll
            for (int m = 0; m < 4; ++m) {
                const int row = row0 + ai * 128 + m * 16;
#pragma unroll
                for (int bj = 0; bj < 2; ++bj) {
                    const int col = col0 + bj * 128;
                    float gt[8]; unpack8(*(const u32x4*)(PC + (size_t)row * PCW + 3072 + col), gt);
                    const f32x4 v0 = acc[ai][bj][m][0], v1 = acc[ai][bj][m][1];
                    float o[8];
#pragma unroll
                    for (int j = 0; j < 4; ++j) { o[j] = sigm(gt[j]) * v0[j]; o[4 + j] = sigm(gt[4 + j]) * v1[j]; }
                    *(u32x4*)(T + (size_t)row * DM + col) = pack8(o);
                }
            }
    }
};

struct EpiGateC {
    static constexpr bool PERM = true, AFTER_DRAIN = false;
    const bf16_t* PC; const bf16_t* T; bf16_t* O;
    __device__ __forceinline__ void operator()(const f32x4 (&acc)[2][2][4][2], const pg8::Unit& u, int wr, int wc, int fr, int fq) const {
        const int row0 = u.pm * 256 + wr * 64 + fr, col0 = u.pn * 256 + wc * 32 + 8 * fq;
#pragma unroll
        for (int ai = 0; ai < 2; ++ai)
#pragma unroll
            for (int m = 0; m < 4; ++m) {
                const int row = row0 + ai * 128 + m * 16;
#pragma unroll
                for (int bj = 0; bj < 2; ++bj) {
                    const int col = col0 + bj * 128;
                    float gt[8]; unpack8(*(const u32x4*)(PC + (size_t)row * PCW + 4096 + col), gt);
                    float tt[8]; unpack8(*(const u32x4*)(T + (size_t)row * DM + col), tt);
                    const f32x4 v0 = acc[ai][bj][m][0], v1 = acc[ai][bj][m][1];
                    float o[8];
#pragma unroll
                    for (int j = 0; j < 4; ++j) { o[j] = tt[j] + sigm(gt[j]) * v0[j]; o[4 + j] = tt[4 + j] + sigm(gt[4 + j]) * v1[j]; }
                    *(u32x4*)(O + (size_t)row * DM + col) = pack8(o);
                }
            }
    }
};

struct EpiSS {
    static constexpr bool PERM = true, AFTER_DRAIN = false;
    bf16_t* O; float* ss;
    __device__ __forceinline__ void operator()(const f32x4 (&acc)[2][2][4][2], const pg8::Unit& u, int wr, int wc, int fr, int fq) const {
        const int row0 = u.pm * 256 + wr * 64 + fr, col0 = u.pn * 256 + wc * 32 + 8 * fq;
#pragma unroll
        for (int ai = 0; ai < 2; ++ai)
#pragma unroll
            for (int m = 0; m < 4; ++m) {
                const int row = row0 + ai * 128 + m * 16;
                float s = 0.f;
#pragma unroll
                for (int bj = 0; bj < 2; ++bj) {
                    const f32x4 v0 = acc[ai][bj][m][0], v1 = acc[ai][bj][m][1];
                    u32x4 w; w.x = pk_bf16(v0[0], v0[1]); w.y = pk_bf16(v0[2], v0[3]); w.z = pk_bf16(v1[0], v1[1]); w.w = pk_bf16(v1[2], v1[3]);
                    *(u32x4*)(O + (size_t)row * DM + col0 + bj * 128) = w;
#pragma unroll
                    for (int j = 0; j < 4; ++j) s += v0[j] * v0[j] + v1[j] * v1[j];
                }
                s += __shfl_xor(s, 16); s += __shfl_xor(s, 32);
                if (fq == 0) atomicAdd(ss + row, s);
            }
    }
};

struct EpiRelu2 {
    static constexpr bool PERM = true, AFTER_DRAIN = false;
    bf16_t* O;
    __device__ __forceinline__ void operator()(const f32x4 (&acc)[2][2][4][2], const pg8::Unit& u, int wr, int wc, int fr, int fq) const {
        const int row0 = u.pm * 256 + wr * 64 + fr, col0 = u.pn * 256 + wc * 32 + 8 * fq;
#pragma unroll
        for (int ai = 0; ai < 2; ++ai)
#pragma unroll
            for (int m = 0; m < 4; ++m) {
                bf16_t* rowp = O + (size_t)(row0 + ai * 128 + m * 16) * DFF + col0;
#pragma unroll
                for (int bj = 0; bj < 2; ++bj) {
                    f32x4 v0 = acc[ai][bj][m][0], v1 = acc[ai][bj][m][1];
#pragma unroll
                    for (int j = 0; j < 4; ++j) { const float a = fmaxf(v0[j], 0.f), b = fmaxf(v1[j], 0.f); v0[j] = a * a; v1[j] = b * b; }
                    u32x4 w; w.x = pk_bf16(v0[0], v0[1]); w.y = pk_bf16(v0[2], v0[3]); w.z = pk_bf16(v1[0], v1[1]); w.w = pk_bf16(v1[2], v1[3]);
                    *(u32x4*)(rowp + bj * 128) = w;
                }
            }
    }
};

__device__ __forceinline__ int win_phys(int n) {
    if (n < 5632 || n >= 7680) return n;
    const int j = n - 5632;
    return j < 1024 ? 5632 + (j >> 7) * 256 + (j & 127) : 5632 + ((j - 1024) >> 7) * 256 + 128 + (j & 127);
}
template <bool PERMUTE_WIN = false>
__device__ __forceinline__ void transpose_item(const float* W, int K, int N, bf16_t* WT, LAS float* scr, int item, int lane) {
    const int nblk = N >> 5, kb = item / nblk, nb = item - kb * nblk, k0 = 64 * kb, n0 = 32 * nb;
    const int n0p = PERMUTE_WIN ? win_phys(n0) : n0;
#pragma unroll 8
    for (int i = 0; i < 32; ++i) { const int kk = 2 * i + (lane >> 5); scr[kk * 33 + (lane & 31)] = W[(size_t)(k0 + kk) * N + n0 + (lane & 31)]; }
    asm volatile("s_waitcnt lgkmcnt(0)" ::: "memory");
    const int c = lane & 7;
#pragma unroll
    for (int j = 0; j < 4; ++j) {
        const int n = (lane >> 3) + 8 * j; const LAS float* s = scr + (8 * c) * 33 + n;
        u32x4 o; o.x = pk_bf16(s[0 * 33], s[1 * 33]); o.y = pk_bf16(s[2 * 33], s[3 * 33]); o.z = pk_bf16(s[4 * 33], s[5 * 33]); o.w = pk_bf16(s[6 * 33], s[7 * 33]);
        *(u32x4*)(WT + (size_t)(n0p + n) * K + k0 + 8 * c) = o;
    }
    asm volatile("s_waitcnt lgkmcnt(0)" ::: "memory");
}

__device__ __forceinline__ void rms_row_bf16(const float* xrow, const float* g, bf16_t* orow, int lane) {
    const f32x4* xr = (const f32x4*)xrow + lane; f32x4 v[4]; float s = 0.f;
#pragma unroll
    for (int j = 0; j < 4; ++j) { v[j] = xr[64 * j]; s += (v[j].x * v[j].x + v[j].y * v[j].y) + (v[j].z * v[j].z + v[j].w * v[j].w); }
    const float rs = rsqrtf(wave_sum(s) * (1.f / DM) + EPS);
#pragma unroll
    for (int j = 0; j < 4; ++j) {
        const f32x4 gg = ((const f32x4*)g)[lane + 64 * j];
        u32x2 o; o.x = pk_bf16(v[j].x * rs * gg.x, v[j].y * rs * gg.y); o.y = pk_bf16(v[j].z * rs * gg.z, v[j].w * rs * gg.w);
        ((u32x2*)orow)[lane + 64 * j] = o;
    }
}

__device__ __forceinline__ void shift_copy(const float* src, float* dst, int L, size_t gtid, size_t gthreads) {
    const size_t per_b = (size_t)L * 256, total = 32 * per_b, valid = (size_t)(L - 1) * 256;
    const f32x4* s4 = (const f32x4*)src; f32x4* d4 = (f32x4*)dst;
#pragma unroll 4
    for (size_t i = gtid; i < total; i += gthreads) {
        const size_t rem = i & (per_b - 1);
        if (rem < valid) { const f32x4 v = __builtin_nontemporal_load(s4 + i + 256); __builtin_nontemporal_store(v, d4 + i); }
    }
}

__device__ __forceinline__ s16x4 vtr(const LAS unsigned char* p) {
    typedef short v4i16_t __attribute__((ext_vector_type(4)));
    return __builtin_bit_cast(s16x4, __builtin_amdgcn_ds_read_tr16_b64_v4i16((LAS v4i16_t*)p));
}
__device__ __forceinline__ int crow(int r, int hi) { return (r & 3) + 8 * (r >> 2) + 4 * hi; }

__device__ __forceinline__ void attn_prompt_task(int task, const bf16_t* Qb, const bf16_t* Kb, const bf16_t* Vb, bf16_t* OG, float* LSE, LAS unsigned char* wl, int lane) {
    const int gh = task >> 9, blk = task & 511, g = gh >> 3, h = gh & 7, sh = 2 * g;
    const int R0 = blk << 5, b = R0 >> 13, off = R0 & 8191, lrb = 13 - sh;
    const int c = off >> lrb, m0 = off & ((1 << lrb) - 1);
    const int qi = lane & 31, hi = lane >> 5;
    const size_t hb = (size_t)gh * RQ;
    bf16x8 qf[4];
    { const bf16_t* qp = Qb + (hb + R0 + qi) * 64 + hi * 8;
#pragma unroll
      for (int ks = 0; ks < 4; ++ks) qf[ks] = *(const bf16x8*)(qp + ks * 16); }
    const int jfirst = m0 >= 128 ? 0 : ((128 - m0) >> 5);
    f32x16 O0, O1;
#pragma unroll
    for (int i = 0; i < 16; ++i) { O0[i] = 0.f; O1[i] = 0.f; }
    float m_run = -1e30f, l_run = 0.f;
    const int kwo = (lane >> 3) * 144 + (lane & 7) * 16;
    const int vwo = 4608 + ((lane & 7) >> 2) * 2048 + (lane >> 3) * 64 + (lane & 3) * 16;
    const int kro = qi * 144 + hi * 16;
    const int vro = 4608 + (4 * hi + ((lane & 15) >> 2)) * 64 + ((lane >> 4) & 1) * 32 + (lane & 3) * 8;
    u32x4 krA[4], vrA[4], krB[4], vrB[4];
    const size_t eb = (hb + (size_t)(R0 - 128)) * 64 + lane * 8;
    {
#pragma unroll
        for (int it = 0; it < 4; ++it) { krA[it] = *(const u32x4*)(Kb + eb + (size_t)jfirst * 2048 + it * 512); vrA[it] = *(const u32x4*)(Vb + eb + (size_t)jfirst * 2048 + it * 512); }
        if (jfirst < 4) {
#pragma unroll
            for (int it = 0; it < 4; ++it) { krB[it] = *(const u32x4*)(Kb + eb + (size_t)(jfirst + 1) * 2048 + it * 512); vrB[it] = *(const u32x4*)(Vb + eb + (size_t)(jfirst + 1) * 2048 + it * 512); }
        }
    }
#define ATT_BLOCK(J, KR, VR) do { const int j = (J); \
        asm volatile("" ::: "memory"); \
        _Pragma("unroll") for (int it = 0; it < 4; ++it) { *(LAS u32x4*)(wl + kwo + it * 8 * 144) = KR[it]; *(LAS u32x4*)(wl + vwo + it * 8 * 64) = VR[it]; } \
        asm volatile("" ::: "memory"); \
        if (j + 2 < 5) { _Pragma("unroll") for (int it = 0; it < 4; ++it) { KR[it] = *(const u32x4*)(Kb + eb + (size_t)(j + 2) * 2048 + it * 512); VR[it] = *(const u32x4*)(Vb + eb + (size_t)(j + 2) * 2048 + it * 512); } } \
        f32x16 S; \
        _Pragma("unroll") for (int i = 0; i < 16; ++i) S[i] = 0.f; \
        _Pragma("unroll") for (int ks = 0; ks < 4; ++ks) { const bf16x8 kf = *(const LAS bf16x8*)(wl + kro + ks * 32); S = __builtin_amdgcn_mfma_f32_32x32x16_bf16(kf, qf[ks], S, 0, 0, 0); } \
        float mx = -1e30f; \
        _Pragma("unroll") for (int i = 0; i < 16; ++i) { const int kk = crow(i, hi); float sv = S[i] * C2; if (j == 0 && kk < qi) sv = -1e30f; if (j == 4 && kk > qi) sv = -1e30f; S[i] = sv; mx = fmaxf(mx, sv); } \
        mx = fmaxf(mx, __shfl_xor(mx, 32)); \
        const float m_new = fmaxf(m_run, mx), corr = __builtin_amdgcn_exp2f(m_run - m_new); \
        float ps = 0.f; \
        _Pragma("unroll") for (int i = 0; i < 16; ++i) { const float p = __builtin_amdgcn_exp2f(S[i] - m_new); S[i] = p; ps += p; } \
        l_run = l_run * corr + ps; m_run = m_new; \
        _Pragma("unroll") for (int i = 0; i < 16; ++i) { O0[i] *= corr; O1[i] *= corr; } \
        bf16x8 pb[2]; \
        _Pragma("unroll") for (int s2 = 0; s2 < 2; ++s2) { u32x4 w; w.x = pk_bf16(S[8 * s2 + 0], S[8 * s2 + 1]); w.y = pk_bf16(S[8 * s2 + 2], S[8 * s2 + 3]); w.z = pk_bf16(S[8 * s2 + 4], S[8 * s2 + 5]); w.w = pk_bf16(S[8 * s2 + 6], S[8 * s2 + 7]); pb[s2] = __builtin_bit_cast(bf16x8, w); } \
        _Pragma("unroll") for (int s2 = 0; s2 < 2; ++s2) { _Pragma("unroll") for (int db = 0; db < 2; ++db) { \
                const s16x4 av = vtr(wl + vro + db * 2048 + s2 * 1024), bq = vtr(wl + vro + db * 2048 + s2 * 1024 + 512); \
                bf16x8 vf; vf[0] = av[0]; vf[1] = av[1]; vf[2] = av[2]; vf[3] = av[3]; vf[4] = bq[0]; vf[5] = bq[1]; vf[6] = bq[2]; vf[7] = bq[3]; \
                if (db == 0) O0 = __builtin_amdgcn_mfma_f32_32x32x16_bf16(vf, pb[s2], O0, 0, 0, 0); else O1 = __builtin_amdgcn_mfma_f32_32x32x16_bf16(vf, pb[s2], O1, 0, 0, 0); } } \
    } while (0)
    for (int j0 = jfirst; j0 < 5; j0 += 2) {
        ATT_BLOCK(j0, krA, vrA);
        if (j0 + 1 < 5) ATT_BLOCK(j0 + 1, krB, vrB);
    }
#undef ATT_BLOCK
    const float l_tot = l_run + __shfl_xor(l_run, 32), inv = 1.f / l_tot;
    const int rown = (b << 13) + (((m0 + qi) << sh) | c);
    bf16_t* op = OG + ((size_t)g * NP + rown) * 512 + h * 64 + 4 * hi;
#pragma unroll
    for (int i4 = 0; i4 < 4; ++i4) {
        u32x2 w0, w1;
        w0.x = pk_bf16(O0[4 * i4 + 0] * inv, O0[4 * i4 + 1] * inv); w0.y = pk_bf16(O0[4 * i4 + 2] * inv, O0[4 * i4 + 3] * inv);
        w1.x = pk_bf16(O1[4 * i4 + 0] * inv, O1[4 * i4 + 1] * inv); w1.y = pk_bf16(O1[4 * i4 + 2] * inv, O1[4 * i4 + 3] * inv);
        *(u32x2*)(op + 8 * i4) = w0; *(u32x2*)(op + 32 + 8 * i4) = w1;
    }
    if (hi == 0) LSE[((size_t)g * NP + rown) * 8 + h] = m_run + log2f(l_tot);
}

__device__ __forceinline__ void attn_sample_task(int task, const bf16_t* Qb, const bf16_t* Kb, const bf16_t* Vb,
                                                 const float* c0, const float* c1, const float* c2, float* SO, float* SL, LAS float* pl, int lane) {
    const int g = task >> 8, b = (task >> 3) & 31, h = task & 7, sh = 2 * g, L = 128 << sh;
    const unsigned long long ca = g == 0 ? (unsigned long long)c0 : (g == 1 ? (unsigned long long)c1 : (unsigned long long)c2);
    const float* cache = (const float*)ca;
    const size_t rowq = ((size_t)(g * 8 + h) * RQ + NP + b) * 64;
    const float qv = bf2f(Qb[rowq + lane]);
    const f32x4* k0p = (const f32x4*)(cache + ((size_t)(b * L + (lane << sh)) * 2) * 512 + h * 64);
    const f32x4* k1p = (const f32x4*)(cache + ((size_t)(b * L + ((lane + 64) << sh)) * 2) * 512 + h * 64);
    f32x4 ka[16], kb[16];
#pragma unroll
    for (int d4 = 0; d4 < 16; ++d4) { ka[d4] = k0p[d4]; kb[d4] = k1p[d4]; }
    float s0 = 0.f, s1 = 0.f;
#pragma unroll
    for (int d4 = 0; d4 < 16; ++d4) {
        const float q0 = __int_as_float(__builtin_amdgcn_readlane(__float_as_int(qv), 4 * d4 + 0)), q1 = __int_as_float(__builtin_amdgcn_readlane(__float_as_int(qv), 4 * d4 + 1));
        const float q2 = __int_as_float(__builtin_amdgcn_readlane(__float_as_int(qv), 4 * d4 + 2)), q3 = __int_as_float(__builtin_amdgcn_readlane(__float_as_int(qv), 4 * d4 + 3));
        s0 += ka[d4].x * q0 + ka[d4].y * q1 + ka[d4].z * q2 + ka[d4].w * q3;
        s1 += kb[d4].x * q0 + kb[d4].y * q1 + kb[d4].z * q2 + kb[d4].w * q3;
    }
    const float kn = bf2f(Kb[rowq + lane]);
    float sn = wave_sum(kn * qv);
    s0 *= C2; s1 *= C2; sn *= C2;
    const float mx = fmaxf(wave_max(fmaxf(s0, s1)), sn);
    const float p0 = exp2f(s0 - mx), p1 = exp2f(s1 - mx), pn = exp2f(sn - mx);
    const float l = wave_sum(p0 + p1) + pn;
    asm volatile("" ::: "memory");
    pl[lane] = p0; pl[64 + lane] = p1;
    asm volatile("s_waitcnt lgkmcnt(0)" ::: "memory");
    const int kq = lane >> 4, d4l = lane & 15;
    const f32x4* vp4 = (const f32x4*)(cache + ((size_t)(b * L) * 2 + 1) * 512 + h * 64) + d4l;
    f32x4 vv[32];
#pragma unroll
    for (int i = 0; i < 32; ++i) vv[i] = vp4[(size_t)((4 * i + kq) << sh) * 256];
    f32x4 oa = {0.f, 0.f, 0.f, 0.f};
#pragma unroll
    for (int i = 0; i < 32; ++i) oa += vv[i] * pl[4 * i + kq];
    asm volatile("s_waitcnt lgkmcnt(0)" ::: "memory");
#pragma unroll
    for (int e = 0; e < 4; ++e) { oa[e] += __shfl_xor(oa[e], 16); oa[e] += __shfl_xor(oa[e], 32); }
    if (lane < 16) {
        const u32x2 vn = *(const u32x2*)(Vb + rowq + 4 * lane);
        const float il = 1.f / l;
        f32x4 o; o.x = (oa.x + pn * bf_lo(vn.x)) * il; o.y = (oa.y + pn * bf_hi(vn.x)) * il; o.z = (oa.z + pn * bf_lo(vn.y)) * il; o.w = (oa.w + pn * bf_hi(vn.y)) * il;
        ((f32x4*)(SO + (size_t)task * 64))[lane] = o;
        if (lane == 0) SL[task] = mx + log2f(l);
    }
}

template <int K>
__device__ __forceinline__ void skinny_tile(const bf16_t* A, int lda, const bf16_t* Bt, int n0, LAS float* red, int wave, int lane, float& r0, float& r1) {
    constexpr int KW = K / 8, NS16 = KW / 16;
    const bf16_t* ap = A + (size_t)(lane & 31) * lda + wave * KW + (lane >> 5) * 8;
    const bf16_t* bp = Bt + (size_t)(n0 + (lane & 31)) * K + wave * KW + (lane >> 5) * 8;
    f32x16 acc;
#pragma unroll
    for (int i = 0; i < 16; ++i) acc[i] = 0.f;
    constexpr int UN = NS16 < 8 ? NS16 : 8;
    for (int s0 = 0; s0 < NS16; s0 += UN) {
        bf16x8 av[UN], bv[UN];
#pragma unroll
        for (int u = 0; u < UN; ++u) { av[u] = *(const bf16x8*)(ap + (s0 + u) * 16); bv[u] = *(const bf16x8*)(bp + (s0 + u) * 16); }
#pragma unroll
        for (int u = 0; u < UN; ++u) acc = __builtin_amdgcn_mfma_f32_32x32x16_bf16(av[u], bv[u], acc, 0, 0, 0);
    }
    const int hi = lane >> 5;
#pragma unroll
    for (int i = 0; i < 16; ++i) red[wave * 1024 + crow(i, hi) * 32 + (lane & 31)] = acc[i];
    __syncthreads();
    const int t = threadIdx.x;
    float a0 = 0.f, a1 = 0.f;
#pragma unroll
    for (int w = 0; w < 8; ++w) { a0 += red[w * 1024 + 2 * t]; a1 += red[w * 1024 + 2 * t + 1]; }
    r0 = a0; r1 = a1;
    __syncthreads();
}

__device__ __forceinline__ void conv_prompt_task(int task, const bf16_t* PC, const float* cw, bf16_t* CV, float* out, int lane) {
    const int strip = task >> 1, col = (task & 1) * 512 + lane * 8;
    const int row_base = strip * 16, t0 = row_base & 8191, b = row_base >> 13;
    float w0[8], w1[8], w2[8], u1[8], u2[8];
    { const f32x4 a = *(const f32x4*)(cw + col), bq = *(const f32x4*)(cw + col + 4);
      const f32x4 c = *(const f32x4*)(cw + 1024 + col), d = *(const f32x4*)(cw + 1024 + col + 4);
      const f32x4 e = *(const f32x4*)(cw + 2048 + col), f = *(const f32x4*)(cw + 2048 + col + 4);
#pragma unroll
      for (int j = 0; j < 4; ++j) { w0[j] = a[j]; w0[4 + j] = bq[j]; w1[j] = c[j]; w1[4 + j] = d[j]; w2[j] = e[j]; w2[4 + j] = f[j]; } }
    if (t0 == 0) {
#pragma unroll
        for (int j = 0; j < 8; ++j) { u1[j] = 0.f; u2[j] = 0.f; }
    } else {
        unpack8(*(const u32x4*)(PC + (size_t)(row_base - 2) * PCW + 1024 + col), u2);
        unpack8(*(const u32x4*)(PC + (size_t)(row_base - 1) * PCW + 1024 + col), u1);
    }
#pragma unroll 4
    for (int r = 0; r < 16; ++r) {
        const size_t row = (size_t)(row_base + r);
        float uu[8], cb[8], o[8];
        unpack8(*(const u32x4*)(PC + row * PCW + 1024 + col), uu); unpack8(*(const u32x4*)(PC + row * PCW + col), cb);
#pragma unroll
        for (int j = 0; j < 8; ++j) { const float u = uu[j]; o[j] = cb[j] * (w0[j] * u2[j] + w1[j] * u1[j] + w2[j] * u); u2[j] = u1[j]; u1[j] = u; }
        *(u32x4*)(CV + row * DM + col) = pack8(o);
        if (t0 + r >= 8190) {
            float* op = out + O_CONVP + (size_t)(b * 2 + (t0 + r - 8190)) * 1024 + col;
            f32x4 x0, x1;
#pragma unroll
            for (int j = 0; j < 4; ++j) { x0[j] = u1[j]; x1[j] = u1[4 + j]; }
            *(f32x4*)op = x0; *(f32x4*)(op + 4) = x1;
        }
    }
}

__device__ __forceinline__ void norm1_row(const float* xrow, const bf16_t* mrow, float ss, const float* gpost, const float* gpre, bf16_t* x1row, bf16_t* h2row, int lane) {
    const float rs1 = rsqrtf(ss * (1.f / DM) + EPS);
    f32x4 v[4]; float s = 0.f;
#pragma unroll
    for (int j = 0; j < 4; ++j) {
        const f32x4 xv = ((const f32x4*)xrow)[lane + 64 * j], gp = ((const f32x4*)gpost)[lane + 64 * j];
        const u32x2 mw = ((const u32x2*)mrow)[lane + 64 * j];
        v[j].x = xv.x + bf_lo(mw.x) * rs1 * gp.x; v[j].y = xv.y + bf_hi(mw.x) * rs1 * gp.y; v[j].z = xv.z + bf_lo(mw.y) * rs1 * gp.z; v[j].w = xv.w + bf_hi(mw.y) * rs1 * gp.w;
        s += (v[j].x * v[j].x + v[j].y * v[j].y) + (v[j].z * v[j].z + v[j].w * v[j].w);
    }
    const float rs2 = rsqrtf(wave_sum(s) * (1.f / DM) + EPS);
#pragma unroll
    for (int j = 0; j < 4; ++j) {
        const f32x4 gg = ((const f32x4*)gpre)[lane + 64 * j];
        { u32x2 xo; xo.x = pk_bf16(v[j].x, v[j].y); xo.y = pk_bf16(v[j].z, v[j].w); ((u32x2*)x1row)[lane + 64 * j] = xo; }
        u32x2 o; o.x = pk_bf16(v[j].x * rs2 * gg.x, v[j].y * rs2 * gg.y); o.y = pk_bf16(v[j].z * rs2 * gg.z, v[j].w * rs2 * gg.w);
        ((u32x2*)h2row)[lane + 64 * j] = o;
    }
}
__device__ __forceinline__ void norm2_row(float* yrow, const bf16_t* x1row, const bf16_t* frow, float ss, const float* gpost, int lane) {
    const float rs = rsqrtf(ss * (1.f / DM) + EPS);
#pragma unroll
    for (int j = 0; j < 4; ++j) {
        const u32x2 xw = ((const u32x2*)x1row)[lane + 64 * j]; const f32x4 gp = ((const f32x4*)gpost)[lane + 64 * j];
        const u32x2 mw = ((const u32x2*)frow)[lane + 64 * j];
        f32x4 xv;
        xv.x = bf_lo(xw.x) + bf_lo(mw.x) * rs * gp.x; xv.y = bf_hi(xw.x) + bf_hi(mw.x) * rs * gp.y; xv.z = bf_lo(xw.y) + bf_lo(mw.y) * rs * gp.z; xv.w = bf_hi(xw.y) + bf_hi(mw.y) * rs * gp.w;
        ((f32x4*)yrow)[lane + 64 * j] = xv;
    }
}

#define WIN ((bf16_t*)(ws + WS_WIN))
#define WAO ((bf16_t*)(ws + WS_WAO))
#define WCO ((bf16_t*)(ws + WS_WCO))
#define WO ((bf16_t*)(ws + WS_WO))
#define WF1 ((bf16_t*)(ws + WS_WF1))
#define WF2 ((bf16_t*)(ws + WS_WF2))
#define H ((bf16_t*)(ws + WS_H))
#define Qb ((bf16_t*)(ws + WS_Q))
#define Kb ((bf16_t*)(ws + WS_K))
#define Vb ((bf16_t*)(ws + WS_V))
#define HID ((bf16_t*)(ws + WS_HID))
#define PC ((bf16_t*)(ws + WS_PC))
#define OG ((bf16_t*)(ws + WS_OG))
#define LSE ((float*)(ws + WS_LSE))
#define ATTN ((bf16_t*)(ws + WS_ATTN))
#define CV ((bf16_t*)(ws + WS_CV))
#define T ((bf16_t*)(ws + WS_T))
#define X1 ((bf16_t*)(ws + WS_T))
#define MIXIN ((bf16_t*)(ws + WS_MIXIN))
#define MIX ((bf16_t*)(ws + WS_MIX))
#define H2 ((bf16_t*)(ws + WS_H2))
#define Fb ((bf16_t*)(ws + WS_F))
#define SS ((float*)(ws + WS_SS))
#ifndef REP_P1
#define REP_P1 1
#endif
#ifndef REP_SYNC
#define REP_SYNC 1
#endif
#ifndef REP_P0
#define REP_P0 1
#endif
#ifndef REP_P2
#define REP_P2 1
#endif
constexpr int CPY_N = 16;
constexpr size_t CPY_T0 = (size_t)32 * 128 * 256, CPY_T1 = CPY_T0 + (size_t)32 * 512 * 256, CPY_TOT = CPY_T1 + (size_t)32 * 2048 * 256;
struct CopyOrder : pg8::StaticOrder {
    const f32x4 *s0, *s1, *s2; f32x4 *d0, *d1, *d2;
    mutable int ui;
    __device__ __forceinline__ bool next(int i, pg8::Unit& u) const {
        if (!pg8::StaticOrder::next(i, u)) return false;
        u.pn += 18; if (u.pn >= INW / 256) u.pn -= INW / 256;
        return true;
    }
    __device__ __forceinline__ void done(const pg8::Unit&) const {
        const size_t base = ((size_t)ui * G + c) * (size_t)(CPY_N * NTHREADS) + threadIdx.x; ++ui;
        f32x4 v[CPY_N];
#pragma unroll
        for (int j = 0; j < CPY_N; ++j) {
            const size_t f = base + (size_t)j * NTHREADS;
            if (f < CPY_T0) { if ((f & (128 * 256 - 1)) < 127 * 256) v[j] = __builtin_nontemporal_load(s0 + f + 256); }
            else if (f < CPY_T1) { const size_t r = f - CPY_T0; if ((r & (512 * 256 - 1)) < 511 * 256) v[j] = __builtin_nontemporal_load(s1 + r + 256); }
            else if (f < CPY_TOT) { const size_t r = f - CPY_T1; if ((r & (2048 * 256 - 1)) < 2047 * 256) v[j] = __builtin_nontemporal_load(s2 + r + 256); }
        }
#pragma unroll
        for (int j = 0; j < CPY_N; ++j) {
            const size_t f = base + (size_t)j * NTHREADS;
            if (f < CPY_T0) { if ((f & (128 * 256 - 1)) < 127 * 256) __builtin_nontemporal_store(v[j], d0 + f); }
            else if (f < CPY_T1) { const size_t r = f - CPY_T0; if ((r & (512 * 256 - 1)) < 511 * 256) __builtin_nontemporal_store(v[j], d1 + r); }
            else if (f < CPY_TOT) { const size_t r = f - CPY_T1; if ((r & (2048 * 256 - 1)) < 2047 * 256) __builtin_nontemporal_store(v[j], d2 + r); }
        }
        asm volatile("s_waitcnt vmcnt(0)" ::: "memory");
    }
};
constexpr size_t CPY_HOOK = (size_t)CPY_N * NTHREADS * ((NP / 256) * (INW / 256));
static_assert(CPY_HOOK >= CPY_T1 && CPY_HOOK <= CPY_TOT, "the tail lies in the third cache");

#define XB_TMO      128
#define XB_XCNT(j)  (256  + 64 * (j))
#define XB_XSUB(j)  (1280 + 64 * (j))
#define XB_XGEN(j)  (2304 + 64 * (j))
#define XB_TOP      3328
#define XB_TOPGEN   3392
#define XCD_BAR_WORDS 3456
#define XB_SPIN_CAP (1u << 18)

__device__ __forceinline__ unsigned xb_ld(unsigned* p)              { return __hip_atomic_load(p, __ATOMIC_RELAXED, __HIP_MEMORY_SCOPE_AGENT); }
__device__ __forceinline__ unsigned xb_add(unsigned* p, unsigned v) { return __hip_atomic_fetch_add(p, v, __ATOMIC_RELAXED, __HIP_MEMORY_SCOPE_AGENT); }
__device__ __forceinline__ unsigned xb_xcc_id() { return (unsigned)__builtin_amdgcn_s_getreg((3 << 11) | 20) & 0xFu; }
#define XB_SPIN(cond, bar) do { unsigned _sp = 0; while (cond) { __builtin_amdgcn_s_sleep(1); \
    if ((++_sp & 255u) == 0u) { if (xb_ld(&(bar)[XB_TMO])) break; if (_sp > XB_SPIN_CAP) { atomicAdd(&(bar)[XB_TMO], 1u); break; } } } } while (0)

struct XcdBarrier {
    unsigned* bar; unsigned x;
    volatile LAS unsigned* st;
};

__device__ __forceinline__ XcdBarrier xcd_barrier_post(unsigned* bar, volatile LAS unsigned* st) {
    XcdBarrier b; b.bar = bar; b.x = xb_xcc_id(); b.st = st;
    if (threadIdx.x == 0) (void)xb_add(&bar[XB_XCNT(b.x)], 1u);
    return b;
}
__device__ __forceinline__ void xcd_barrier_complete(unsigned* bar, unsigned x, unsigned& nloc, unsigned& nx) {
    const unsigned G = gridDim.x * gridDim.y * gridDim.z;
    unsigned sum, cnt, mine, sp = 0u;
    for (;;) {
        sum = 0u; cnt = 0u; mine = 0u;
#pragma unroll
        for (unsigned j = 0; j < 16; ++j) { const unsigned c = xb_ld(&bar[XB_XCNT(j)]); sum += c; cnt += (c > 0u) ? 1u : 0u; mine = (j == x) ? c : mine; }
        if (sum == G) break;
        __builtin_amdgcn_s_sleep(1);
        if ((++sp & 255u) == 0u) { if (xb_ld(&bar[XB_TMO])) break; if (sp > XB_SPIN_CAP) { atomicAdd(&bar[XB_TMO], 1u); break; } }
    }
    nloc = mine > 0u ? mine : 1u; nx = cnt > 0u ? cnt : 1u;
}

__device__ __forceinline__ void xcd_barrier(const XcdBarrier& b) {
    asm volatile("s_waitcnt vmcnt(0)" ::: "memory");
    __syncthreads();
    if (threadIdx.x == 0) {
        unsigned* bar = b.bar;
        __builtin_amdgcn_s_waitcnt(0);
        unsigned nloc = b.st[0], nx = b.st[1];
        if (nloc == 0u) { xcd_barrier_complete(bar, b.x, nloc, nx); b.st[0] = nloc; b.st[1] = nx; }
        const unsigned old = xb_add(&bar[XB_XSUB(b.x)], 1u);
        const unsigned gen = old / nloc;
        if (old + 1u == (gen + 1u) * nloc) {
            __builtin_amdgcn_fence(__ATOMIC_RELEASE, "agent");
            asm volatile("s_waitcnt vmcnt(0)" ::: "memory");
            const unsigned og = xb_add(&bar[XB_TOP], 1u);
            const unsigned tg = og / nx;
            if (og + 1u == (tg + 1u) * nx) xb_add(&bar[XB_TOPGEN], 1u);
            else XB_SPIN(xb_ld(&bar[XB_TOPGEN]) == tg, bar);
            __builtin_amdgcn_fence(__ATOMIC_ACQUIRE, "agent");
            xb_add(&bar[XB_XGEN(b.x)], 1u);
            asm volatile("s_waitcnt vmcnt(0)" ::: "memory");
        } else {
            XB_SPIN(xb_ld(&bar[XB_XGEN(b.x)]) == gen, bar);
            __builtin_amdgcn_fence(__ATOMIC_ACQUIRE, "agent");
            asm volatile("s_waitcnt vmcnt(0)" ::: "memory");
        }
    }
    __syncthreads();
}

struct Args { const float* in[17]; float* out; unsigned char* ws; };

__global__ void __launch_bounds__(NTHREADS, 2) fwd_kernel(Args a) {
    extern __shared__ __attribute__((aligned(16))) unsigned char lds_raw[];
    cg::grid_group grid = cg::this_grid();
    LAS unsigned char* lds = (LAS unsigned char*)lds_raw;
    const int tid = threadIdx.x, lane = tid & 63, wave = __builtin_amdgcn_readfirstlane(tid >> 6);
    const int G = gridDim.x, gw = blockIdx.x * 8 + wave, NGW = G * 8;
    const size_t gtid = (size_t)blockIdx.x * NTHREADS + tid, gthreads = (size_t)G * NTHREADS;
    unsigned char* ws = a.ws; float* out = a.out;
    volatile LAS unsigned* bst = (volatile LAS unsigned*)(lds + 131072);
    if (tid == 0) { bst[0] = 0u; bst[1] = 0u; }
    __syncthreads();
    XcdBarrier xbar = xcd_barrier_post((unsigned*)(ws + WS_BAR), bst);
    if (a.ws == nullptr) grid.sync();
    {
        LAS float* scr = (LAS float*)(lds + wave * 8448);
        constexpr int I_IN = (DM / 64) * (INW / 32);
        for (int it = gw; it < I_IN; it += NGW) transpose_item<true>(a.in[6], DM, INW, WIN, scr, it, lane);
        for (int m = gw; m < NP + NS; m += NGW) {
            const float* xr = m < NP ? a.in[0] + (size_t)m * DM : a.in[1] + (size_t)(m - NP) * DM;
            rms_row_bf16(xr, a.in[13], H + (size_t)m * DM, lane);
        }
        for (size_t i = gtid; i < (size_t)2 * MPAD; i += gthreads) SS[i] = 0.f;
    }
    xcd_barrier(xbar);

    {
        const int sb = ((int)blockIdx.x + G - (G >> 1)) % G;
        for (int tile = sb; tile < INW / 32; tile += (G >> 1)) {
            if (sb >= (G >> 1)) break;
            float r0, r1; skinny_tile<DM>(H + (size_t)NP * DM, DM, WIN, tile * 32, (LAS float*)lds, wave, lane, r0, r1);
            const int b = tid >> 4, col = tile * 32 + 2 * (tid & 15);
            if (col < 4608) {
                const int which = col / 1536, cin = col - which * 1536, g = cin >> 9, h = (cin >> 6) & 7, d = cin & 63;
                *(unsigned*)(Qb + (size_t)which * (QKV_SZ / 2) + ((size_t)(g * 8 + h) * RQ + NP + b) * 64 + d) = pk_bf16(r0, r1);
                if (which) {
                    const int L = 128 << (2 * g); const size_t ob = g == 0 ? O_KV128S : (g == 1 ? O_KV512S : O_KV2048S);
                    float* o = out + ob + (((size_t)b * L + (L - 1)) * 2 + (which - 1)) * 512 + h * 64 + d;
                    o[0] = r0; o[1] = r1;
                }
            } else {
                *(unsigned*)(PC + (size_t)(NP + b) * PCW + (col - 4608)) = pk_bf16(r0, r1);
            }
        }
        pg8::Gemm g{H, WIN, NP, INW, DM}; CopyOrder S; S.init(NP, INW, G, (int)blockIdx.x);
        S.s0 = (const f32x4*)a.in[2]; S.s1 = (const f32x4*)a.in[3]; S.s2 = (const f32x4*)a.in[4];
        S.d0 = (f32x4*)(out + O_KV128S); S.d1 = (f32x4*)(out + O_KV512S); S.d2 = (f32x4*)(out + O_KV2048S); S.ui = 0;
        EpiIn E{Qb, PC};
        pg8::gemm_phase<EpiIn, CopyOrder, true, true>(lds, g, S, E);
        if ((int)blockIdx.x >= (G >> 1)) {
            const int tid = threadIdx.x, lane = tid & 63, wave = __builtin_amdgcn_readfirstlane(tid >> 6);
            LAS float* scr = (LAS float*)(lds + wave * 8448);
            constexpr int I_AO = (512 / 64) * (DM / 32), I_CO = (DM / 64) * (DM / 32), I_O = I_CO, I_F1 = (DM / 64) * (DFF / 32), I_F2 = (DFF / 64) * (DM / 32);
            constexpr int NIT = I_AO + I_CO + I_O + I_F1 + I_F2;
            const int hw = ((int)blockIdx.x - (G >> 1)) * 8 + wave, HW = (G - (G >> 1)) * 8;
            for (int it = hw; it < NIT; it += HW) {
                int r = it;
                if (r < I_AO) { transpose_item(a.in[8], 512, DM, WAO, scr, r, lane); continue; } r -= I_AO;
                if (r < I_CO) { transpose_item(a.in[9], DM, DM, WCO, scr, r, lane); continue; } r -= I_CO;
                if (r < I_O) { transpose_item(a.in[10], DM, DM, WO, scr, r, lane); continue; } r -= I_O;
                if (r < I_F1) { transpose_item(a.in[11], DM, DFF, WF1, scr, r, lane); continue; } r -= I_F1;
                transpose_item(a.in[12], DFF, DM, WF2, scr, r, lane);
            }
            const size_t ht = (size_t)((int)blockIdx.x - (G >> 1)) * NTHREADS + tid, HT = (size_t)(G - (G >> 1)) * NTHREADS;
            const f32x4* s2 = (const f32x4*)a.in[4]; f32x4* d2 = (f32x4*)(out + O_KV2048S);
#pragma unroll 4
            for (size_t f = CPY_HOOK + ht; f < CPY_TOT; f += HT) {
                const size_t r = f - CPY_T1;
                if ((r & (2048 * 256 - 1)) < 2047 * 256) { const f32x4 v = __builtin_nontemporal_load(s2 + r + 256); __builtin_nontemporal_store(v, d2 + r); }
            }
        }
    }
    xcd_barrier(xbar);

    {
        LAS unsigned char* wl = lds + wave * 8704;
        for (int t = gw; t < 3 * 8 * 512; t += NGW) attn_prompt_task(t, Qb, Kb, Vb, OG, LSE, wl, lane);
#if REP_P2 == 2
        for (int t = gw; t < 3 * 8 * 512; t += NGW) attn_prompt_task(t, Qb, Kb, Vb, OG, LSE, wl, lane);
#endif
        for (int t = NGW - 1 - gw; t < 768; t += NGW) attn_sample_task(t, Qb, Kb, Vb, a.in[2], a.in[3], a.in[4], (float*)(ws + WS_SO), (float*)(ws + WS_SO) + 768 * 64, (LAS float*)wl, lane);
        for (int t = gw; t < 2048; t += NGW) conv_prompt_task(t, PC, a.in[7], CV, out, lane);
        for (size_t i = gtid; i < 32 * 128; i += gthreads) {
            const int b = (int)(i >> 7), col = (int)(i & 127) * 8; const size_t row = (size_t)(NP + b);
            float cc[8], ch[8], cb[8], o[8];
            const int pcol = 1024 + (col >> 7) * 256 + (col & 127);
            unpack8(*(const u32x4*)(PC + row * PCW + pcol), cc); unpack8(*(const u32x4*)(PC + row * PCW + pcol + 128), ch); unpack8(*(const u32x4*)(PC + row * PCW + col), cb);
            const float* st = a.in[5] + (size_t)b * 2048 + col; const float* cw = a.in[7] + col;
            float* oc = out + O_CONVS + (size_t)b * 2048 + col;
#pragma unroll
            for (int j = 0; j < 8; ++j) {
                const float u = cc[j] * ch[j], s0 = st[j], s1 = st[1024 + j];
                o[j] = cb[j] * (cw[j] * s0 + cw[1024 + j] * s1 + cw[2048 + j] * u);
                oc[j] = s1; oc[1024 + j] = u;
            }
            *(u32x4*)(CV + row * DM + col) = pack8(o);
        }
#pragma unroll
        for (int g = 0; g < 3; ++g) {
            const int sh = 2 * g, W = 128 << sh; float* dst = out + (g == 0 ? O_KV128P : (g == 1 ? O_KV512P : O_KV2048P));
            for (size_t i = gtid; i < (size_t)256 * W; i += gthreads) {
                const int d8 = (int)(i & 7), h = (int)(i >> 3) & 7, kv = (int)(i >> 6) & 1; const int br = (int)(i >> 7), r = br & (W - 1), b = br >> (7 + sh);
                const int t = 8192 - W + r, rowp = (b << 13) | ((t & ((1 << sh) - 1)) << (13 - sh)) | (t >> sh);
                float f[8]; unpack8(*(const u32x4*)((kv ? Vb : Kb) + ((size_t)(g * 8 + h) * RQ + rowp) * 64 + d8 * 8), f);
                float* o = dst + i * 8;
                *(f32x4*)o = (f32x4){f[0], f[1], f[2], f[3]}; *(f32x4*)(o + 4) = (f32x4){f[4], f[5], f[6], f[7]};
            }
        }
    }
    xcd_barrier(xbar);

    for (size_t i = gtid; i < (size_t)NP * 64; i += gthreads) {
        const size_t row = i >> 6; const int hd = (int)(i & 63), h = hd >> 3;
        const float L0 = LSE[row * 8 + h], L1 = LSE[((size_t)NP + row) * 8 + h], L2 = LSE[((size_t)2 * NP + row) * 8 + h];
        const float M = fmaxf(fmaxf(L0, L1), L2);
        float w0 = exp2f(L0 - M), w1 = exp2f(L1 - M), w2 = exp2f(L2 - M); const float inv = 1.f / (w0 + w1 + w2); w0 *= inv; w1 *= inv; w2 *= inv;
        float x0[8], x1[8], x2[8], o[8];
        unpack8(*(const u32x4*)(OG + row * 512 + hd * 8), x0); unpack8(*(const u32x4*)(OG + ((size_t)NP + row) * 512 + hd * 8), x1); unpack8(*(const u32x4*)(OG + ((size_t)2 * NP + row) * 512 + hd * 8), x2);
#pragma unroll
        for (int j = 0; j < 8; ++j) o[j] = w0 * x0[j] + w1 * x1[j] + w2 * x2[j];
        *(u32x4*)(ATTN + row * 512 + hd * 8) = pack8(o);
    }
    {
        const float* SO = (const float*)(ws + WS_SO); const float* SL = SO + 768 * 64;
        for (size_t i = gtid; i < (size_t)NS * 8 * 64; i += gthreads) {
            const int bh = (int)(i >> 6), d = (int)(i & 63);
            const float L0 = SL[bh], L1 = SL[256 + bh], L2 = SL[512 + bh];
            const float M = fmaxf(fmaxf(L0, L1), L2);
            const float w0 = exp2f(L0 - M), w1 = exp2f(L1 - M), w2 = exp2f(L2 - M);
            const float o = (w0 * SO[(size_t)bh * 64 + d] + w1 * SO[(size_t)(256 + bh) * 64 + d] + w2 * SO[(size_t)(512 + bh) * 64 + d]) / (w0 + w1 + w2);
            ATTN[(size_t)(NP + (bh >> 3)) * 512 + (bh & 7) * 64 + d] = (bf16_t)(pk_bf16(o, 0.f) & 0xffffu);
        }
    }
    xcd_barrier(xbar);

    {
        if ((int)blockIdx.x < DM / 32) {
            const int n0 = (int)blockIdx.x * 32; float a0, a1, c0, c1;
            skinny_tile<512>(ATTN + (size_t)NP * 512, 512, WAO, n0, (LAS float*)lds, wave, lane, a0, a1);
            skinny_tile<DM>(CV + (size_t)NP * DM, DM, WCO, n0, (LAS float*)lds, wave, lane, c0, c1);
            const int b = tid >> 4, col = n0 + 2 * (tid & 15);
            const unsigned ga = *(const unsigned*)(PC + (size_t)(NP + b) * PCW + 3072 + col), gc = *(const unsigned*)(PC + (size_t)(NP + b) * PCW + 4096 + col);
            *(unsigned*)(MIXIN + (size_t)(NP + b) * DM + col) = pk_bf16(sigm(bf_lo(ga)) * a0 + sigm(bf_lo(gc)) * c0, sigm(bf_hi(ga)) * a1 + sigm(bf_hi(gc)) * c1);
        }
        pg8::StaticOrder S; S.init(NP, DM, G, (int)blockIdx.x);
        { pg8::Gemm g{ATTN, WAO, NP, DM, 512}; EpiGateA E{PC, T}; pg8::gemm_phase<EpiGateA, pg8::StaticOrder, true, true>(lds, g, S, E); }
        { pg8::Gemm g{CV, WCO, NP, DM, DM}; EpiGateC E{PC, T, MIXIN}; pg8::gemm_phase<EpiGateC, pg8::StaticOrder, true, true>(lds, g, S, E); }
    }
    xcd_barrier(xbar);

    {
        if ((int)blockIdx.x < DM / 32) {
            const int n0 = (int)blockIdx.x * 32; float r0, r1;
            skinny_tile<DM>(MIXIN + (size_t)NP * DM, DM, WO, n0, (LAS float*)lds, wave, lane, r0, r1);
            const int b = tid >> 4, col = n0 + 2 * (tid & 15);
            *(unsigned*)(MIX + (size_t)(NP + b) * DM + col) = pk_bf16(r0, r1);
            float sq = r0 * r0 + r1 * r1; sq += __shfl_xor(sq, 1); sq += __shfl_xor(sq, 2); sq += __shfl_xor(sq, 4); sq += __shfl_xor(sq, 8);
            if ((tid & 15) == 0) atomicAdd(SS + NP + b, sq);
        }
        pg8::Gemm g{MIXIN, WO, NP, DM, DM}; pg8::StaticOrder S; S.init(NP, DM, G, (int)blockIdx.x);
        EpiSS E{MIX, SS};
        pg8::gemm_phase<EpiSS, pg8::StaticOrder, true, true>(lds, g, S, E);
    }
    xcd_barrier(xbar);

    for (int m = gw; m < NP + NS; m += NGW) {
        const float* xr = m < NP ? a.in[0] + (size_t)m * DM : a.in[1] + (size_t)(m - NP) * DM;
        norm1_row(xr, MIX + (size_t)m * DM, SS[m], a.in[14], a.in[15], X1 + (size_t)m * DM, H2 + (size_t)m * DM, lane);
    }
    xcd_barrier(xbar);

    {
        if ((int)blockIdx.x < DFF / 32) {
            const int n0 = (int)blockIdx.x * 32; float r0, r1;
            skinny_tile<DM>(H2 + (size_t)NP * DM, DM, WF1, n0, (LAS float*)lds, wave, lane, r0, r1);
            const int b = tid >> 4, col = n0 + 2 * (tid & 15);
            r0 = fmaxf(r0, 0.f); r1 = fmaxf(r1, 0.f);
            *(unsigned*)(HID + (size_t)(NP + b) * DFF + col) = pk_bf16(r0 * r0, r1 * r1);
        }
        pg8::Gemm g{H2, WF1, NP, DFF, DM}; pg8::StaticOrder S; S.init(NP, DFF, G, (int)blockIdx.x);
        EpiRelu2 E{HID};
        pg8::gemm_phase<EpiRelu2, pg8::StaticOrder, true, true>(lds, g, S, E);
    }
    xcd_barrier(xbar);

    {
        if ((int)blockIdx.x < DM / 32) {
            const int n0 = (int)blockIdx.x * 32; float r0, r1;
            skinny_tile<DFF>(HID + (size_t)NP * DFF, DFF, WF2, n0, (LAS float*)lds, wave, lane, r0, r1);
            const int b = tid >> 4, col = n0 + 2 * (tid & 15);
            *(unsigned*)(Fb + (size_t)(NP + b) * DM + col) = pk_bf16(r0, r1);
            float sq = r0 * r0 + r1 * r1; sq += __shfl_xor(sq, 1); sq += __shfl_xor(sq, 2); sq += __shfl_xor(sq, 4); sq += __shfl_xor(sq, 8);
            if ((tid & 15) == 0) atomicAdd(SS + MPAD + NP + b, sq);
        }
        pg8::Gemm g{HID, WF2, NP, DM, DFF}; pg8::StaticOrder S; S.init(NP, DM, G, (int)blockIdx.x);
        EpiSS E{Fb, SS + MPAD};
        pg8::gemm_phase<EpiSS, pg8::StaticOrder, true, true>(lds, g, S, E);
    }
    xcd_barrier(xbar);

    for (int m = gw; m < NP + NS; m += NGW) {
        float* yr = m < NP ? out + O_YP + (size_t)m * DM : out + O_YS + (size_t)(m - NP) * DM;
        norm2_row(yr, X1 + (size_t)m * DM, Fb + (size_t)m * DM, SS[MPAD + m], a.in[16], lane);
    }
}

extern "C" void kernel_launch(void* const* d_in, const int* in_sizes, int n_in, void* d_out, int out_size, void* d_ws, size_t ws_size, hipStream_t stream) {
    static int grid_blocks = 0;
    if (grid_blocks == 0) {
        if (n_in != 17 || ws_size < WS_END) { fprintf(stderr, "kernel_launch: unexpected n_in %d or ws_size %zu (< %zu)\n", n_in, ws_size, (size_t)WS_END); grid_blocks = -1; return; }
        int dev = 0, cus = 0, per_cu = 0;
        hipGetDevice(&dev);
        hipDeviceGetAttribute(&cus, hipDeviceAttributeMultiprocessorCount, dev);
        if (hipFuncSetAttribute((const void*)fwd_kernel, hipFuncAttributeMaxDynamicSharedMemorySize, LDS_BYTES) != hipSuccess) { fprintf(stderr, "kernel_launch: hipFuncSetAttribute failed\n"); grid_blocks = -1; return; }
        if (hipOccupancyMaxActiveBlocksPerMultiprocessor(&per_cu, (const void*)fwd_kernel, NTHREADS, LDS_BYTES) != hipSuccess || per_cu < 1) { fprintf(stderr, "kernel_launch: occupancy query failed (%d)\n", per_cu); per_cu = 1; (void)hipGetLastError(); }
        if (per_cu > 1) per_cu = 1;
        grid_blocks = cus * per_cu;
    }
    if (grid_blocks < 0) return;
    if (hipMemsetAsync((char*)d_ws + WS_BAR, 0, 16384, stream) != hipSuccess) { fprintf(stderr, "kernel_launch: memset failed\n"); return; }
    Args a{};
    for (int i = 0; i < 17; ++i) a.in[i] = (const float*)d_in[i];
    a.out = (float*)d_out; a.ws = (unsigned char*)d_ws;
    void* args[] = {&a};
    hipError_t e = hipLaunchCooperativeKernel((const void*)fwd_kernel, dim3(grid_blocks), dim3(NTHREADS), args, LDS_BYTES, stream);
    if (e != hipSuccess) fprintf(stderr, "cooperative launch failed: %s (grid %d)\n", hipGetErrorString(e), grid_blocks);
}
```

```cpp
#include <hip/hip_runtime.h>
#include <hip/hip_cooperative_groups.h>
#include <cstdio>
#include <cstdint>
namespace cg = cooperative_groups;
namespace pg8 {
#define PG8_LAS __attribute__((address_space(3)))
typedef unsigned short bf16_t;
typedef short bf16x8 __attribute__((ext_vector_type(8)));
typedef float f32x4 __attribute__((ext_vector_type(4)));
typedef unsigned u32x4 __attribute__((ext_vector_type(4)));
constexpr int BM = 256, BK = 64, HALF = 128, HTB = HALF * BK * 2  , STAGE_BYTES = 8 * HTB, NXCD = 8, WGM = 8;

__host__ __device__ __forceinline__ int lds_byte(int r, int c) { const int st = (r >> 4) * 2 + (c >> 5), rr = r & 15, cc = c & 31, ob = rr * 64 + cc * 2; return st * 1024 + (ob ^ (((ob >> 9) & 1) << 5)); }
__host__ __device__ __forceinline__ void stage_rc(int b, int& R, int& C) { const int st = b / 1024, sb = b % 1024, swz = sb ^ (((sb >> 9) & 1) << 5); R = (st >> 1) * 16 + swz / 64; C = (st & 1) * 32 + (swz % 64) / 2; }
__host__ __device__ __forceinline__ int perm32(int rho) { const int n = rho >> 4, i = rho & 15; return 8 * (i >> 2) + 4 * n + (i & 3); }

struct Unit { int pm, pn; };
struct Gemm { const bf16_t* A; const bf16_t* Bt; int M, N, K; };

struct StaticOrder {
    int nM, nN, nwg, G, c;
    __host__ __device__ void init(int M, int N, int G_, int c_) { nM = M / BM; nN = N / BM; nwg = nM * nN; G = G_; c = c_; }
    __host__ __device__ bool next(int i, Unit& u) const {
        const long L = (long)i * G + c; if (L >= nwg) return false;
        int wgid = (int)L; { const int q = nwg / NXCD, r = nwg % NXCD, xcd = wgid % NXCD, off = wgid / NXCD; wgid = (xcd < r ? xcd * (q + 1) : r * (q + 1) + (xcd - r) * q) + off; }
        const int nig = WGM * nN, gid = wgid / nig, fm = gid * WGM, gsz = (nM - fm) < WGM ? (nM - fm) : WGM;
        u.pm = fm + ((wgid % nig) % gsz); u.pn = (wgid % nig) / gsz; return true;
    }
    __device__ __forceinline__ void a_ready(const Unit&) const {}
    __device__ __forceinline__ void done(const Unit&) const {}
};
__device__ __forceinline__ unsigned cvt_pk_bf16(float lo, float hi) { unsigned r; asm volatile("v_cvt_pk_bf16_f32 %0, %1, %2" : "=v"(r) : "v"(lo), "v"(hi)); return r; }
template <class Epi, class Sched, bool ALIGN_EPI = false, bool SP2 = false>
__device__ __forceinline__ void gemm_phase(PG8_LAS unsigned char* lds, const Gemm g, const Sched& S, const Epi& E) {
    int tid_ = threadIdx.x; asm volatile("" : "+v"(tid_));
    const int tid = tid_, wid = __builtin_amdgcn_readfirstlane(tid >> 6), lane = tid & 63, wr = wid >> 2, wc = wid & 3, fr = lane & 15, fq = lane >> 4;
    const int K = g.K, nt = K / BK;
    unsigned voffA[2], voffB[2];
#pragma unroll
    for (int i = 0; i < 2; ++i) { int R, C; stage_rc(tid * 16 + i * 8192, R, C); const int Rb = Epi::PERM ? ((R & ~31) + perm32(R & 31)) : R;
        voffA[i] = (unsigned)(R * K + C) * 2u; voffB[i] = (unsigned)(Rb * K + C) * 2u; }
    const size_t kstep = (size_t)(BK * 2);
    const size_t hstep = (size_t)HALF * K * 2;
    const size_t tstep = 2 * hstep;
    const unsigned ldsw = (unsigned)wid * 1024u;
    const int aoff = lds_byte(wr * 64 + fr, fq * 8), boff = lds_byte(wc * 32 + fr, fq * 8);
#define PG8_SA(b, h) (((b) * 2 + (h)) * HTB)
#define PG8_SB(b, h) ((4 + (b) * 2 + (h)) * HTB)
#define PG8_STAGE(bufoff, gbase, voff) do { _Pragma("unroll") for (int _i = 0; _i < 2; ++_i) \
        __builtin_amdgcn_global_load_lds((const unsigned*)((const char*)(gbase) + (voff)[_i]), (PG8_LAS unsigned*)(lds + (bufoff) + ldsw + _i * 8192), 16, 0, 0); } while (0)
#define PG8_LDA(dst, b, h) do { _Pragma("unroll") for (int m = 0; m < 4; ++m) _Pragma("unroll") for (int k = 0; k < 2; ++k) dst[m][k] = *(const PG8_LAS bf16x8*)(lds + PG8_SA(b, h) + aoff + m * 2048 + k * 1024); } while (0)
#define PG8_LDB(dst, b, h) do { _Pragma("unroll") for (int n = 0; n < 2; ++n) _Pragma("unroll") for (int k = 0; k < 2; ++k) dst[n][k] = *(const PG8_LAS bf16x8*)(lds + PG8_SB(b, h) + boff + n * 2048 + k * 1024); } while (0)
#define PG8_MMA(ai, bj, At, Bt) do { __builtin_amdgcn_s_setprio(1); _Pragma("unroll") for (int m = 0; m < 4; ++m) _Pragma("unroll") for (int n = 0; n < 2; ++n) _Pragma("unroll") for (int k = 0; k < 2; ++k) \
        acc[ai][bj][m][n] = __builtin_amdgcn_mfma_f32_16x16x32_bf16(Bt[n][k], At[m][k], acc[ai][bj][m][n], 0, 0, 0); __builtin_amdgcn_s_setprio(0); } while (0)
#define PG8_WAIT_V(n) asm volatile("s_waitcnt vmcnt(" #n ")" ::: "memory")
#define PG8_WAIT_L(n) asm volatile("s_waitcnt lgkmcnt(" #n ")" ::: "memory")
#define PG8_BAR __builtin_amdgcn_s_barrier()
#define PG8_SCHED __builtin_amdgcn_sched_barrier(0)
    Unit cur, nxt; int ui = 0;
    if (!S.next(0, cur)) return;
    f32x4 acc[2][2][4][2];
#pragma unroll
    for (int a = 0; a < 2; ++a)
#pragma unroll
        for (int b = 0; b < 2; ++b)
#pragma unroll
            for (int m = 0; m < 4; ++m)
#pragma unroll
                for (int n = 0; n < 2; ++n) acc[a][b][m][n] = (f32x4){0.f, 0.f, 0.f, 0.f};
    bf16x8 At[4][2], B0[2][2], B1[2][2];
    const char* cA = (const char*)g.A + (size_t)cur.pm * tstep; const char* cB = (const char*)g.Bt + (size_t)cur.pn * tstep;
    S.a_ready(cur);
    if constexpr (SP2) {
        PG8_STAGE(PG8_SB(0, 0), cB, voffB); PG8_STAGE(PG8_SB(0, 1), cB + hstep, voffB); PG8_STAGE(PG8_SA(0, 0), cA, voffA); PG8_STAGE(PG8_SA(0, 1), cA + hstep, voffA);
        if (wr == 1) PG8_BAR;
        PG8_WAIT_V(2); PG8_BAR;
        PG8_STAGE(PG8_SB(1, 0), cB + kstep, voffB); PG8_STAGE(PG8_SA(1, 0), cA + kstep, voffA); PG8_STAGE(PG8_SB(1, 1), cB + hstep + kstep, voffB);
        PG8_WAIT_V(6); PG8_BAR;
    } else {
        PG8_STAGE(PG8_SB(0, 0), cB, voffB); PG8_STAGE(PG8_SA(0, 0), cA, voffA); PG8_STAGE(PG8_SB(0, 1), cB + hstep, voffB); PG8_STAGE(PG8_SA(0, 1), cA + hstep, voffA);
        if (wr == 1) PG8_BAR;
        PG8_WAIT_V(4); PG8_BAR;
        PG8_STAGE(PG8_SB(1, 0), cB + kstep, voffB); PG8_STAGE(PG8_SA(1, 0), cA + kstep, voffA); PG8_STAGE(PG8_SB(1, 1), cB + hstep + kstep, voffB);
        PG8_WAIT_V(6); PG8_BAR;
    }
    for (;;) {
        const bool has_next = S.next(ui + 1, nxt);
        const char* nA = has_next ? (const char*)g.A + (size_t)nxt.pm * tstep : cA; const char* nB = has_next ? (const char*)g.Bt + (size_t)nxt.pn * tstep : cB;
        for (int t = 0; t < nt; t += 2) {
            const bool last = (t == nt - 2);
            const char* a1 = cA + (size_t)(t + 1) * kstep;
            const char* a2 = last ? nA : cA + (size_t)(t + 2) * kstep; const char* b2 = last ? nB : cB + (size_t)(t + 2) * kstep;
            const char* a3 = a2 + kstep; const char* b3 = b2 + kstep;
            if (last && has_next) S.a_ready(nxt);
            if constexpr (SP2) {
            PG8_LDB(B0, 0, 0); PG8_LDB(B1, 0, 1); PG8_SCHED; PG8_LDA(At, 0, 0); PG8_STAGE(PG8_SA(1, 1), a1 + hstep, voffA);
            PG8_WAIT_V(8); PG8_WAIT_L(0); PG8_BAR; PG8_MMA(0, 0, At, B0); PG8_MMA(0, 1, At, B1); PG8_BAR; PG8_SCHED;
            PG8_LDA(At, 0, 1); PG8_STAGE(PG8_SB(0, 0), b2, voffB); PG8_STAGE(PG8_SB(0, 1), b2 + hstep, voffB); PG8_STAGE(PG8_SA(0, 0), a2, voffA);
            PG8_WAIT_V(8); PG8_WAIT_L(0); PG8_BAR; PG8_MMA(1, 0, At, B0); PG8_MMA(1, 1, At, B1); PG8_BAR; PG8_SCHED;
            PG8_LDB(B0, 1, 0); PG8_LDB(B1, 1, 1); PG8_SCHED; PG8_LDA(At, 1, 0); PG8_STAGE(PG8_SA(0, 1), a2 + hstep, voffA);
            PG8_WAIT_V(8); PG8_WAIT_L(0); PG8_BAR; PG8_MMA(0, 0, At, B0); PG8_MMA(0, 1, At, B1); PG8_BAR; PG8_SCHED;
            PG8_LDA(At, 1, 1); PG8_STAGE(PG8_SB(1, 0), b3, voffB); PG8_STAGE(PG8_SB(1, 1), b3 + hstep, voffB); PG8_STAGE(PG8_SA(1, 0), a3, voffA);
            PG8_WAIT_V(8); PG8_WAIT_L(0); PG8_BAR; PG8_MMA(1, 0, At, B0); PG8_MMA(1, 1, At, B1); PG8_BAR; PG8_SCHED;
            } else {
            PG8_LDB(B0, 0, 0); PG8_SCHED; PG8_LDA(At, 0, 0); PG8_STAGE(PG8_SA(1, 1), a1 + hstep, voffA);
            PG8_WAIT_L(8); PG8_BAR; PG8_WAIT_L(0); PG8_MMA(0, 0, At, B0); PG8_BAR; PG8_SCHED;
            PG8_LDB(B1, 0, 1); PG8_STAGE(PG8_SB(0, 0), b2, voffB);
            PG8_BAR; PG8_WAIT_L(0); PG8_MMA(0, 1, At, B1); PG8_BAR;
            PG8_LDA(At, 0, 1); PG8_STAGE(PG8_SA(0, 0), a2, voffA);
            PG8_BAR; PG8_WAIT_L(0); PG8_MMA(1, 0, At, B0); PG8_BAR; PG8_SCHED;
            PG8_STAGE(PG8_SB(0, 1), b2 + hstep, voffB);
            PG8_WAIT_V(6); PG8_BAR; PG8_MMA(1, 1, At, B1); PG8_BAR;
            PG8_LDB(B0, 1, 0); PG8_SCHED; PG8_LDA(At, 1, 0); PG8_STAGE(PG8_SA(0, 1), a2 + hstep, voffA);
            PG8_WAIT_L(8); PG8_BAR; PG8_WAIT_L(0); PG8_MMA(0, 0, At, B0); PG8_BAR; PG8_SCHED;
            PG8_LDB(B1, 1, 1); PG8_STAGE(PG8_SB(1, 0), b3, voffB);
            PG8_BAR; PG8_WAIT_L(0); PG8_MMA(0, 1, At, B1); PG8_BAR;
            PG8_LDA(At, 1, 1); PG8_STAGE(PG8_SA(1, 0), a3, voffA);
            PG8_BAR; PG8_WAIT_L(0); PG8_MMA(1, 0, At, B0); PG8_BAR; PG8_SCHED;
            PG8_STAGE(PG8_SB(1, 1), b3 + hstep, voffB);
            PG8_WAIT_V(6); PG8_BAR; PG8_MMA(1, 1, At, B1); PG8_BAR;
            }
        }
        if constexpr (ALIGN_EPI) { if (wr == 0) PG8_BAR; }
        if constexpr (!Epi::AFTER_DRAIN) { E(acc, cur, wr, wc, fr, fq); S.done(cur); }
        if (!has_next) break;
#pragma unroll
        for (int a = 0; a < 2; ++a)
#pragma unroll
            for (int b = 0; b < 2; ++b)
#pragma unroll
                for (int m = 0; m < 4; ++m)
#pragma unroll
                    for (int n = 0; n < 2; ++n) acc[a][b][m][n] = (f32x4){0.f, 0.f, 0.f, 0.f};
        cur = nxt; cA = nA; cB = nB; ++ui;
        if constexpr (ALIGN_EPI) { if (wr == 1) PG8_BAR; }
    }
    PG8_WAIT_V(0);
    if constexpr (!ALIGN_EPI) { if (wr == 0) PG8_BAR; }
    PG8_BAR;
    if constexpr (Epi::AFTER_DRAIN) { E.fused(acc, cur, wr, wc, fr, fq, lds, wid, lane); S.done(cur); }
#undef PG8_SA
#undef PG8_SB
#undef PG8_STAGE
#undef PG8_LDA
#undef PG8_LDB
#undef PG8_MMA
#undef PG8_WAIT_V
#undef PG8_WAIT_L
#undef PG8_BAR
#undef PG8_SCHED
}
}

#define LAS __attribute__((address_space(3)))
typedef unsigned short bf16_t;
typedef float f32x4 __attribute__((ext_vector_type(4)));
typedef float f32x16 __attribute__((ext_vector_type(16)));
typedef unsigned u32x4 __attribute__((ext_vector_type(4)));
typedef unsigned u32x2 __attribute__((ext_vector_type(2)));
typedef short bf16x8 __attribute__((ext_vector_type(8)));
typedef short s16x4 __attribute__((ext_vector_type(4)));

constexpr int NP = 16384, NS = 32, MPAD = 16640, DM = 1024, INW = 9728, DFF = 4096, RQ = 16640, PCW = 5120;
constexpr float EPS = 1e-6f;
constexpr float C2 = 0.125f * 1.4426950408889634f;
constexpr int LDS_BYTES = 131072 + 256;
constexpr int NTHREADS = 512;

constexpr size_t O_YP = 0, O_YS = 16777216, O_KV128P = 16809984, O_KV512P = 17072128, O_KV2048P = 18120704, O_CONVP = 22315008,
                 O_KV128S = 22319104, O_KV512S = 26513408, O_KV2048S = 43290624, O_CONVS = 110399488;

constexpr size_t WS_WIN = 0;
constexpr size_t WS_WAO = WS_WIN + (size_t)INW * DM * 2;
constexpr size_t WS_WCO = WS_WAO + (size_t)DM * 512 * 2;
constexpr size_t WS_WO = WS_WCO + (size_t)DM * DM * 2;
constexpr size_t WS_WF1 = WS_WO + (size_t)DM * DM * 2;
constexpr size_t WS_WF2 = WS_WF1 + (size_t)DFF * DM * 2;
constexpr size_t WS_H = WS_WF2 + (size_t)DFF * DM * 2;
constexpr size_t QKV_SZ = (size_t)24 * RQ * 64 * 2;
constexpr size_t WS_Q = WS_H + (size_t)MPAD * DM * 2;
constexpr size_t WS_K = WS_Q + QKV_SZ, WS_V = WS_K + QKV_SZ;
constexpr size_t WS_HID = WS_Q;
constexpr size_t WS_PC = WS_V + QKV_SZ;
constexpr size_t WS_OG = WS_PC + (size_t)MPAD * PCW * 2;
constexpr size_t WS_LSE = WS_OG + (size_t)3 * NP * 512 * 2;
constexpr size_t WS_ATTN = WS_LSE + (size_t)3 * NP * 8 * 4;
constexpr size_t WS_CV = WS_ATTN + (size_t)MPAD * 512 * 2;
constexpr size_t WS_T = WS_CV + (size_t)MPAD * DM * 2;
constexpr size_t WS_MIXIN = WS_T + (size_t)MPAD * DM * 4;
constexpr size_t WS_MIX = WS_MIXIN + (size_t)MPAD * DM * 2;
constexpr size_t WS_H2 = WS_MIX + (size_t)MPAD * DM * 2;
constexpr size_t WS_F = WS_H2 + (size_t)MPAD * DM * 2;
constexpr size_t WS_SS = WS_F + (size_t)MPAD * DM * 2;
constexpr size_t WS_BAR = WS_SS + (size_t)2 * MPAD * 4;
constexpr size_t WS_SO = WS_BAR + 16384;
constexpr size_t WS_END = WS_SO + (size_t)(768 * 64 + 768) * 4;
static_assert((size_t)MPAD * DFF * 2 <= 3 * QKV_SZ, "hid overlay");

__device__ __forceinline__ size_t gtid_now() { int t = threadIdx.x; asm volatile("" : "+v"(t)); return (size_t)blockIdx.x * 512 + t; }
__device__ __forceinline__ unsigned pk_bf16(float lo, float hi) { return pg8::cvt_pk_bf16(lo, hi); }
__device__ __forceinline__ float bf_lo(unsigned w) { return __uint_as_float(w << 16); }
__device__ __forceinline__ float bf_hi(unsigned w) { return __uint_as_float(w & 0xffff0000u); }
__device__ __forceinline__ float bf2f(bf16_t v) { return __uint_as_float((unsigned)v << 16); }
__device__ __forceinline__ float sigm(float x) { return 1.f / (1.f + __expf(-x)); }
__device__ __forceinline__ void unpack8(const u32x4 w, float (&f)[8]) {
    f[0] = bf_lo(w.x); f[1] = bf_hi(w.x); f[2] = bf_lo(w.y); f[3] = bf_hi(w.y); f[4] = bf_lo(w.z); f[5] = bf_hi(w.z); f[6] = bf_lo(w.w); f[7] = bf_hi(w.w);
}
__device__ __forceinline__ u32x4 pack8(const float (&f)[8]) {
    u32x4 w; w.x = pk_bf16(f[0], f[1]); w.y = pk_bf16(f[2], f[3]); w.z = pk_bf16(f[4], f[5]); w.w = pk_bf16(f[6], f[7]); return w;
}
__device__ __forceinline__ float wave_sum(float v) {
#pragma unroll
    for (int o = 1; o < 64; o <<= 1) v += __shfl_xor(v, o);
    return v;
}
__device__ __forceinline__ float wave_max(float v) {
#pragma unroll
    for (int o = 1; o < 64; o <<= 1) v = fmaxf(v, __shfl_xor(v, o));
    return v;
}

struct EpiIn {
    static constexpr bool PERM = true, AFTER_DRAIN = false;
    bf16_t *Q, *PC;
    __device__ __forceinline__ void operator()(const f32x4 (&acc)[2][2][4][2], const pg8::Unit& u, int wr, int wc, int fr, int fq) const {
        const int colt = u.pn * 256, row0 = u.pm * 256 + wr * 64 + fr;
        if (colt < 4608) {
            const int which = colt / 1536, cin = colt - which * 1536;
            bf16_t* base = Q + (size_t)which * (QKV_SZ / 2);
            const int g = cin >> 9, sh = 2 * g;
#pragma unroll
            for (int ai = 0; ai < 2; ++ai)
#pragma unroll
                for (int m = 0; m < 4; ++m) {
                    const int row = row0 + ai * 128 + m * 16;
                    const int rowp = row < NP ? ((row & ~8191) | ((row & ((1 << sh) - 1)) << (13 - sh)) | ((row & 8191) >> sh)) : row;
#pragma unroll
                    for (int bj = 0; bj < 2; ++bj) {
                        const int cgc = cin + bj * 128 + wc * 32 + 8 * fq, h = (cgc >> 6) & 7, d = cgc & 63;
                        const f32x4 v0 = acc[ai][bj][m][0], v1 = acc[ai][bj][m][1];
                        u32x4 w; w.x = pk_bf16(v0[0], v0[1]); w.y = pk_bf16(v0[2], v0[3]); w.z = pk_bf16(v1[0], v1[1]); w.w = pk_bf16(v1[2], v1[3]);
                        *(u32x4*)(base + ((size_t)(g * 8 + h) * RQ + rowp) * 64 + d) = w;
                    }
                }
        } else if (colt >= 5632 && colt < 7680) {
            const int c0 = 1024 + ((colt - 5632) >> 8) * 128 + wc * 32 + 8 * fq;
#pragma unroll
            for (int ai = 0; ai < 2; ++ai)
#pragma unroll
                for (int m = 0; m < 4; ++m) {
                    const f32x4 v0 = acc[ai][0][m][0] * acc[ai][1][m][0], v1 = acc[ai][0][m][1] * acc[ai][1][m][1];
                    u32x4 w; w.x = pk_bf16(v0[0], v0[1]); w.y = pk_bf16(v0[2], v0[3]); w.z = pk_bf16(v1[0], v1[1]); w.w = pk_bf16(v1[2], v1[3]);
                    *(u32x4*)(PC + (size_t)(row0 + ai * 128 + m * 16) * PCW + c0) = w;
                }
        } else {
            const int c0 = colt - 4608 + wc * 32 + 8 * fq;
#pragma unroll
            for (int ai = 0; ai < 2; ++ai)
#pragma unroll
                for (int m = 0; m < 4; ++m) {
                    bf16_t* rowp = PC + (size_t)(row0 + ai * 128 + m * 16) * PCW + c0;
#pragma unroll
                    for (int bj = 0; bj < 2; ++bj) {
                        const f32x4 v0 = acc[ai][bj][m][0], v1 = acc[ai][bj][m][1];
                        u32x4 w; w.x = pk_bf16(v0[0], v0[1]); w.y = pk_bf16(v0[2], v0[3]); w.z = pk_bf16(v1[0], v1[1]); w.w = pk_bf16(v1[2], v1[3]);
                        *(u32x4*)(rowp + bj * 128) = w;
                    }
                }
        }
    }
};

struct EpiGateA {
    static constexpr bool PERM = true, AFTER_DRAIN = false;
    const bf16_t* PC; bf16_t* T;
    __device__ __forceinline__ void operator()(const f32x4 (&acc)[2][2][4][2], const pg8::Unit& u, int wr, int wc, int fr, int fq) const {
        const int row0 = u.pm * 256 + wr * 64 + fr, col0 = u.pn * 256 + wc * 32 + 8 * fq;
#pragma unroll
        for (int ai = 0; ai < 2; ++ai)
#pragma unroll
            for (int m = 0; m < 4; ++m) {
                const int row = row0 + ai * 128 + m * 16;
#pragma unroll
                for (int bj = 0; bj < 2; ++bj) {
                    const int col = col0 + bj * 128;
                    float gt[8]; unpack8(*(const u32x4*)(PC + (size_t)row * PCW + 3072 + col), gt);
                    const f32x4 v0 = acc[ai][bj][m][0], v1 = acc[ai][bj][m][1];
                    float o[8];
#pragma unroll
                    for (int j = 0; j < 4; ++j) { o[j] = sigm(gt[j]) * v0[j]; o[4 + j] = sigm(gt[4 + j]) * v1[j]; }
                    *(u32x4*)(T + (size_t)row * DM + col) = pack8(o);
                }
            }
    }
};

struct EpiGateC {
    static constexpr bool PERM = true, AFTER_DRAIN = false;
    const bf16_t* PC; const bf16_t* T; bf16_t* O;
    __device__ __forceinline__ void operator()(const f32x4 (&acc)[2][2][4][2], const pg8::Unit& u, int wr, int wc, int fr, int fq) const {
        const int row0 = u.pm * 256 + wr * 64 + fr, col0 = u.pn * 256 + wc * 32 + 8 * fq;
#pragma unroll
        for (int ai = 0; ai < 2; ++ai)
#pragma unroll
            for (int m = 0; m < 4; ++m) {
                const int row = row0 + ai * 128 + m * 16;
#pragma unroll
                for (int bj = 0; bj < 2; ++bj) {
                    const int col = col0 + bj * 128;
                    float gt[8]; unpack8(*(const u32x4*)(PC + (size_t)row * PCW + 4096 + col), gt);
                    float tt[8]; unpack8(*(const u32x4*)(T + (size_t)row * DM + col), tt);
                    const f32x4 v0 = acc[ai][bj][m][0], v1 = acc[ai][bj][m][1];
                    float o[8];
#pragma unroll
                    for (int j = 0; j < 4; ++j) { o[j] = tt[j] + sigm(gt[j]) * v0[j]; o[4 + j] = tt[4 + j] + sigm(gt[4 + j]) * v1[j]; }
                    *(u32x4*)(O + (size_t)row * DM + col) = pack8(o);
                }
            }
    }
};

struct EpiSS {
    static constexpr bool PERM = true, AFTER_DRAIN = false;
    bf16_t* O; float* ss;
    __device__ __forceinline__ void operator()(const f32x4 (&acc)[2][2][4][2], const pg8::Unit& u, int wr, int wc, int fr, int fq) const {
        const int row0 = u.pm * 256 + wr * 64 + fr, col0 = u.pn * 256 + wc * 32 + 8 * fq;
#pragma unroll
        for (int ai = 0; ai < 2; ++ai)
#pragma unroll
            for (int m = 0; m < 4; ++m) {
                const int row = row0 + ai * 128 + m * 16;
                float s = 0.f;
#pragma unroll
                for (int bj = 0; bj < 2; ++bj) {
                    const f32x4 v0 = acc[ai][bj][m][0], v1 = acc[ai][bj][m][1];
                    u32x4 w; w.x = pk_bf16(v0[0], v0[1]); w.y = pk_bf16(v0[2], v0[3]); w.z = pk_bf16(v1[0], v1[1]); w.w = pk_bf16(v1[2], v1[3]);
                    *(u32x4*)(O + (size_t)row * DM + col0 + bj * 128) = w;
#pragma unroll
                    for (int j = 0; j < 4; ++j) s += v0[j] * v0[j] + v1[j] * v1[j];
                }
                s += __shfl_xor(s, 16); s += __shfl_xor(s, 32);
                if (fq == 0) atomicAdd(ss + row, s);
            }
    }
};

struct EpiRelu2 {
    static constexpr bool PERM = true, AFTER_DRAIN = false;
    bf16_t* O; const float* rs;
    __device__ __forceinline__ void operator()(const f32x4 (&acc)[2][2][4][2], const pg8::Unit& u, int wr, int wc, int fr, int fq) const {
        const int row0 = u.pm * 256 + wr * 64 + fr, col0 = u.pn * 256 + wc * 32 + 8 * fq;
#pragma unroll
        for (int ai = 0; ai < 2; ++ai)
#pragma unroll
            for (int m = 0; m < 4; ++m) {
                bf16_t* rowp = O + (size_t)(row0 + ai * 128 + m * 16) * DFF + col0;
                const float sc = rs[row0 + ai * 128 + m * 16], sc2 = sc * sc;
#pragma unroll
                for (int bj = 0; bj < 2; ++bj) {
                    f32x4 v0 = acc[ai][bj][m][0], v1 = acc[ai][bj][m][1];
#pragma unroll
                    for (int j = 0; j < 4; ++j) { const float a = fmaxf(v0[j], 0.f), b = fmaxf(v1[j], 0.f); v0[j] = a * a * sc2; v1[j] = b * b * sc2; }
                    u32x4 w; w.x = pk_bf16(v0[0], v0[1]); w.y = pk_bf16(v0[2], v0[3]); w.z = pk_bf16(v1[0], v1[1]); w.w = pk_bf16(v1[2], v1[3]);
                    *(u32x4*)(rowp + bj * 128) = w;
                }
            }
    }
};

__device__ __forceinline__ int win_phys(int n) {
    if (n < 5632 || n >= 7680) return n;
    const int j = n - 5632;
    return j < 1024 ? 5632 + (j >> 7) * 256 + (j & 127) : 5632 + ((j - 1024) >> 7) * 256 + 128 + (j & 127);
}
template <bool PERMUTE_WIN = false, bool SCALE_K = false>
__device__ __forceinline__ void transpose_item(const float* W, int K, int N, bf16_t* WT, LAS float* scr, int item, int lane, const float* gk = nullptr) {
    const int nblk = N >> 5, kb = item / nblk, nb = item - kb * nblk, k0 = 64 * kb, n0 = 32 * nb;
    const int n0p = PERMUTE_WIN ? win_phys(n0) : n0;
#pragma unroll 8
    for (int i = 0; i < 32; ++i) { const int kk = 2 * i + (lane >> 5); float wv = W[(size_t)(k0 + kk) * N + n0 + (lane & 31)]; if (SCALE_K) wv *= gk[k0 + kk]; scr[kk * 33 + (lane & 31)] = wv; }
    asm volatile("s_waitcnt lgkmcnt(0)" ::: "memory");
    const int c = lane & 7;
#pragma unroll
    for (int j = 0; j < 4; ++j) {
        const int n = (lane >> 3) + 8 * j; const LAS float* s = scr + (8 * c) * 33 + n;
        u32x4 o; o.x = pk_bf16(s[0 * 33], s[1 * 33]); o.y = pk_bf16(s[2 * 33], s[3 * 33]); o.z = pk_bf16(s[4 * 33], s[5 * 33]); o.w = pk_bf16(s[6 * 33], s[7 * 33]);
        *(u32x4*)(WT + (size_t)(n0p + n) * K + k0 + 8 * c) = o;
    }
    asm volatile("s_waitcnt lgkmcnt(0)" ::: "memory");
}

__device__ __forceinline__ void rms_row_bf16(const float* xrow, const float* g, bf16_t* orow, int lane) {
    const f32x4* xr = (const f32x4*)xrow + lane; f32x4 v[4]; float s = 0.f;
#pragma unroll
    for (int j = 0; j < 4; ++j) { v[j] = xr[64 * j]; s += (v[j].x * v[j].x + v[j].y * v[j].y) + (v[j].z * v[j].z + v[j].w * v[j].w); }
    const float rs = rsqrtf(wave_sum(s) * (1.f / DM) + EPS);
#pragma unroll
    for (int j = 0; j < 4; ++j) {
        const f32x4 gg = ((const f32x4*)g)[lane + 64 * j];
        u32x2 o; o.x = pk_bf16(v[j].x * rs * gg.x, v[j].y * rs * gg.y); o.y = pk_bf16(v[j].z * rs * gg.z, v[j].w * rs * gg.w);
        ((u32x2*)orow)[lane + 64 * j] = o;
    }
}

__device__ __forceinline__ void shift_copy(const float* src, float* dst, int L, size_t gtid, size_t gthreads) {
    const size_t per_b = (size_t)L * 256, total = 32 * per_b, valid = (size_t)(L - 1) * 256;
    const f32x4* s4 = (const f32x4*)src; f32x4* d4 = (f32x4*)dst;
#pragma unroll 4
    for (size_t i = gtid_now(); i < total; i += gthreads) {
        const size_t rem = i & (per_b - 1);
        if (rem < valid) { const f32x4 v = __builtin_nontemporal_load(s4 + i + 256); __builtin_nontemporal_store(v, d4 + i); }
    }
}

__device__ __forceinline__ s16x4 vtr(const LAS unsigned char* p) {
    typedef short v4i16_t __attribute__((ext_vector_type(4)));
    return __builtin_bit_cast(s16x4, __builtin_amdgcn_ds_read_tr16_b64_v4i16((LAS v4i16_t*)p));
}
__device__ __forceinline__ int crow(int r, int hi) { return (r & 3) + 8 * (r >> 2) + 4 * hi; }

__device__ __forceinline__ void attn_prompt_task(int task, const bf16_t* Qb, const bf16_t* Kb, const bf16_t* Vb, bf16_t* OG, float* LSE, LAS unsigned char* wl, int lane) {
    const int gh = task >> 9, blk = task & 511, g = gh >> 3, h = gh & 7, sh = 2 * g;
    const int R0 = blk << 5, b = R0 >> 13, off = R0 & 8191, lrb = 13 - sh;
    const int c = off >> lrb, m0 = off & ((1 << lrb) - 1);
    const int qi = lane & 31, hi = lane >> 5;
    const size_t hb = (size_t)gh * RQ;
    bf16x8 qf[4];
    { const bf16_t* qp = Qb + (hb + R0 + qi) * 64 + hi * 8;
#pragma unroll
      for (int ks = 0; ks < 4; ++ks) qf[ks] = *(const bf16x8*)(qp + ks * 16); }
    const int jfirst = m0 >= 128 ? 0 : ((128 - m0) >> 5);
    f32x16 O0, O1;
#pragma unroll
    for (int i = 0; i < 16; ++i) { O0[i] = 0.f; O1[i] = 0.f; }
    float m_run = -1e30f, l_run = 0.f;
    const int kwo = (lane >> 3) * 144 + (lane & 7) * 16;
    const int vwo = 4608 + ((lane & 7) >> 2) * 2048 + (lane >> 3) * 64 + (lane & 3) * 16;
    const int kro = qi * 144 + hi * 16;
    const int vro = 4608 + (4 * hi + ((lane & 15) >> 2)) * 64 + ((lane >> 4) & 1) * 32 + (lane & 3) * 8;
    u32x4 krA[4], vrA[4], krB[4], vrB[4];
    const size_t eb = (hb + (size_t)(R0 - 128)) * 64 + lane * 8;
    {
#pragma unroll
        for (int it = 0; it < 4; ++it) { krA[it] = *(const u32x4*)(Kb + eb + (size_t)jfirst * 2048 + it * 512); vrA[it] = *(const u32x4*)(Vb + eb + (size_t)jfirst * 2048 + it * 512); }
        if (jfirst < 4) {
#pragma unroll
            for (int it = 0; it < 4; ++it) { krB[it] = *(const u32x4*)(Kb + eb + (size_t)(jfirst + 1) * 2048 + it * 512); vrB[it] = *(const u32x4*)(Vb + eb + (size_t)(jfirst + 1) * 2048 + it * 512); }
        }
    }
#define ATT_BLOCK(J, KR, VR) do { const int j = (J); \
        asm volatile("" ::: "memory"); \
        _Pragma("unroll") for (int it = 0; it < 4; ++it) { *(LAS u32x4*)(wl + kwo + it * 8 * 144) = KR[it]; *(LAS u32x4*)(wl + vwo + it * 8 * 64) = VR[it]; } \
        asm volatile("" ::: "memory"); \
        if (j + 2 < 5) { _Pragma("unroll") for (int it = 0; it < 4; ++it) { KR[it] = *(const u32x4*)(Kb + eb + (size_t)(j + 2) * 2048 + it * 512); VR[it] = *(const u32x4*)(Vb + eb + (size_t)(j + 2) * 2048 + it * 512); } } \
        f32x16 S; \
        _Pragma("unroll") for (int i = 0; i < 16; ++i) S[i] = 0.f; \
        _Pragma("unroll") for (int ks = 0; ks < 4; ++ks) { const bf16x8 kf = *(const LAS bf16x8*)(wl + kro + ks * 32); S = __builtin_amdgcn_mfma_f32_32x32x16_bf16(kf, qf[ks], S, 0, 0, 0); } \
        float mx = -1e30f; \
        _Pragma("unroll") for (int i = 0; i < 16; ++i) { const int kk = crow(i, hi); float sv = S[i] * C2; if (j == 0 && kk < qi) sv = -1e30f; if (j == 4 && kk > qi) sv = -1e30f; S[i] = sv; mx = fmaxf(mx, sv); } \
        mx = fmaxf(mx, __shfl_xor(mx, 32)); \
        const float m_new = fmaxf(m_run, mx), corr = __builtin_amdgcn_exp2f(m_run - m_new); \
        float ps = 0.f; \
        _Pragma("unroll") for (int i = 0; i < 16; ++i) { const float p = __builtin_amdgcn_exp2f(S[i] - m_new); S[i] = p; ps += p; } \
        l_run = l_run * corr + ps; m_run = m_new; \
        _Pragma("unroll") for (int i = 0; i < 16; ++i) { O0[i] *= corr; O1[i] *= corr; } \
        bf16x8 pb[2]; \
        _Pragma("unroll") for (int s2 = 0; s2 < 2; ++s2) { u32x4 w; w.x = pk_bf16(S[8 * s2 + 0], S[8 * s2 + 1]); w.y = pk_bf16(S[8 * s2 + 2], S[8 * s2 + 3]); w.z = pk_bf16(S[8 * s2 + 4], S[8 * s2 + 5]); w.w = pk_bf16(S[8 * s2 + 6], S[8 * s2 + 7]); pb[s2] = __builtin_bit_cast(bf16x8, w); } \
        _Pragma("unroll") for (int s2 = 0; s2 < 2; ++s2) { _Pragma("unroll") for (int db = 0; db < 2; ++db) { \
                const s16x4 av = vtr(wl + vro + db * 2048 + s2 * 1024), bq = vtr(wl + vro + db * 2048 + s2 * 1024 + 512); \
                bf16x8 vf; vf[0] = av[0]; vf[1] = av[1]; vf[2] = av[2]; vf[3] = av[3]; vf[4] = bq[0]; vf[5] = bq[1]; vf[6] = bq[2]; vf[7] = bq[3]; \
                if (db == 0) O0 = __builtin_amdgcn_mfma_f32_32x32x16_bf16(vf, pb[s2], O0, 0, 0, 0); else O1 = __builtin_amdgcn_mfma_f32_32x32x16_bf16(vf, pb[s2], O1, 0, 0, 0); } } \
    } while (0)
    for (int j0 = jfirst; j0 < 5; j0 += 2) {
        ATT_BLOCK(j0, krA, vrA);
        if (j0 + 1 < 5) ATT_BLOCK(j0 + 1, krB, vrB);
    }
#undef ATT_BLOCK
    const float l_tot = l_run + __shfl_xor(l_run, 32), inv = 1.f / l_tot;
    const int rown = (b << 13) + (((m0 + qi) << sh) | c);
    bf16_t* op = OG + ((size_t)g * NP + rown) * 512 + h * 64 + 4 * hi;
#pragma unroll
    for (int i4 = 0; i4 < 4; ++i4) {
        u32x2 w0, w1;
        w0.x = pk_bf16(O0[4 * i4 + 0] * inv, O0[4 * i4 + 1] * inv); w0.y = pk_bf16(O0[4 * i4 + 2] * inv, O0[4 * i4 + 3] * inv);
        w1.x = pk_bf16(O1[4 * i4 + 0] * inv, O1[4 * i4 + 1] * inv); w1.y = pk_bf16(O1[4 * i4 + 2] * inv, O1[4 * i4 + 3] * inv);
        *(u32x2*)(op + 8 * i4) = w0; *(u32x2*)(op + 32 + 8 * i4) = w1;
    }
    if (hi == 0) LSE[((size_t)g * NP + rown) * 8 + h] = m_run + log2f(l_tot);
}

__device__ __forceinline__ void attn_sample_task(int task, const bf16_t* Qb, const bf16_t* Kb, const bf16_t* Vb,
                                                 const float* c0, const float* c1, const float* c2, float* SO, float* SL, LAS float* pl, int lane) {
    const int g = task >> 8, b = (task >> 3) & 31, h = task & 7, sh = 2 * g, L = 128 << sh;
    const unsigned long long ca = g == 0 ? (unsigned long long)c0 : (g == 1 ? (unsigned long long)c1 : (unsigned long long)c2);
    const float* cache = (const float*)ca;
    const size_t rowq = ((size_t)(g * 8 + h) * RQ + NP + b) * 64;
    const float qv = bf2f(Qb[rowq + lane]);
    const f32x4* k0p = (const f32x4*)(cache + ((size_t)(b * L + (lane << sh)) * 2) * 512 + h * 64);
    const f32x4* k1p = (const f32x4*)(cache + ((size_t)(b * L + ((lane + 64) << sh)) * 2) * 512 + h * 64);
    f32x4 ka[16], kb[16];
#pragma unroll
    for (int d4 = 0; d4 < 16; ++d4) { ka[d4] = k0p[d4]; kb[d4] = k1p[d4]; }
    float s0 = 0.f, s1 = 0.f;
#pragma unroll
    for (int d4 = 0; d4 < 16; ++d4) {
        const float q0 = __int_as_float(__builtin_amdgcn_readlane(__float_as_int(qv), 4 * d4 + 0)), q1 = __int_as_float(__builtin_amdgcn_readlane(__float_as_int(qv), 4 * d4 + 1));
        const float q2 = __int_as_float(__builtin_amdgcn_readlane(__float_as_int(qv), 4 * d4 + 2)), q3 = __int_as_float(__builtin_amdgcn_readlane(__float_as_int(qv), 4 * d4 + 3));
        s0 += ka[d4].x * q0 + ka[d4].y * q1 + ka[d4].z * q2 + ka[d4].w * q3;
        s1 += kb[d4].x * q0 + kb[d4].y * q1 + kb[d4].z * q2 + kb[d4].w * q3;
    }
    const float kn = bf2f(Kb[rowq + lane]);
    float sn = wave_sum(kn * qv);
    s0 *= C2; s1 *= C2; sn *= C2;
    const float mx = fmaxf(wave_max(fmaxf(s0, s1)), sn);
    const float p0 = exp2f(s0 - mx), p1 = exp2f(s1 - mx), pn = exp2f(sn - mx);
    const float l = wave_sum(p0 + p1) + pn;
    asm volatile("" ::: "memory");
    pl[lane] = p0; pl[64 + lane] = p1;
    asm volatile("s_waitcnt lgkmcnt(0)" ::: "memory");
    const int kq = lane >> 4, d4l = lane & 15;
    const f32x4* vp4 = (const f32x4*)(cache + ((size_t)(b * L) * 2 + 1) * 512 + h * 64) + d4l;
    f32x4 vv[32];
#pragma unroll
    for (int i = 0; i < 32; ++i) vv[i] = vp4[(size_t)((4 * i + kq) << sh) * 256];
    f32x4 oa = {0.f, 0.f, 0.f, 0.f};
#pragma unroll
    for (int i = 0; i < 32; ++i) oa += vv[i] * pl[4 * i + kq];
    asm volatile("s_waitcnt lgkmcnt(0)" ::: "memory");
#pragma unroll
    for (int e = 0; e < 4; ++e) { oa[e] += __shfl_xor(oa[e], 16); oa[e] += __shfl_xor(oa[e], 32); }
    if (lane < 16) {
        const u32x2 vn = *(const u32x2*)(Vb + rowq + 4 * lane);
        const float il = 1.f / l;
        f32x4 o; o.x = (oa.x + pn * bf_lo(vn.x)) * il; o.y = (oa.y + pn * bf_hi(vn.x)) * il; o.z = (oa.z + pn * bf_lo(vn.y)) * il; o.w = (oa.w + pn * bf_hi(vn.y)) * il;
        ((f32x4*)(SO + (size_t)task * 64))[lane] = o;
        if (lane == 0) SL[task] = mx + log2f(l);
    }
}

template <int K>
__device__ __forceinline__ void skinny_tile(const bf16_t* A, int lda, const bf16_t* Bt, int n0, LAS float* red, int wave, int lane, float& r0, float& r1) {
    constexpr int KW = K / 8, NS16 = KW / 16;
    const bf16_t* ap = A + (size_t)(lane & 31) * lda + wave * KW + (lane >> 5) * 8;
    const bf16_t* bp = Bt + (size_t)(n0 + (lane & 31)) * K + wave * KW + (lane >> 5) * 8;
    f32x16 acc;
#pragma unroll
    for (int i = 0; i < 16; ++i) acc[i] = 0.f;
    constexpr int UN = NS16 < 8 ? NS16 : 8;
    for (int s0 = 0; s0 < NS16; s0 += UN) {
        bf16x8 av[UN], bv[UN];
#pragma unroll
        for (int u = 0; u < UN; ++u) { av[u] = *(const bf16x8*)(ap + (s0 + u) * 16); bv[u] = *(const bf16x8*)(bp + (s0 + u) * 16); }
#pragma unroll
        for (int u = 0; u < UN; ++u) acc = __builtin_amdgcn_mfma_f32_32x32x16_bf16(av[u], bv[u], acc, 0, 0, 0);
    }
    const int hi = lane >> 5;
#pragma unroll
    for (int i = 0; i < 16; ++i) red[wave * 1024 + crow(i, hi) * 32 + (lane & 31)] = acc[i];
    __syncthreads();
    const int t = threadIdx.x;
    float a0 = 0.f, a1 = 0.f;
#pragma unroll
    for (int w = 0; w < 8; ++w) { a0 += red[w * 1024 + 2 * t]; a1 += red[w * 1024 + 2 * t + 1]; }
    r0 = a0; r1 = a1;
    __syncthreads();
}

__device__ __forceinline__ void conv_prompt_task(int task, const bf16_t* PC, const float* cw, bf16_t* CV, float* out, int lane) {
    const int strip = task >> 1, col = (task & 1) * 512 + lane * 8;
    const int row_base = strip * 16, t0 = row_base & 8191, b = row_base >> 13;
    float w0[8], w1[8], w2[8], u1[8], u2[8];
    { const f32x4 a = *(const f32x4*)(cw + col), bq = *(const f32x4*)(cw + col + 4);
      const f32x4 c = *(const f32x4*)(cw + 1024 + col), d = *(const f32x4*)(cw + 1024 + col + 4);
      const f32x4 e = *(const f32x4*)(cw + 2048 + col), f = *(const f32x4*)(cw + 2048 + col + 4);
#pragma unroll
      for (int j = 0; j < 4; ++j) { w0[j] = a[j]; w0[4 + j] = bq[j]; w1[j] = c[j]; w1[4 + j] = d[j]; w2[j] = e[j]; w2[4 + j] = f[j]; } }
    if (t0 == 0) {
#pragma unroll
        for (int j = 0; j < 8; ++j) { u1[j] = 0.f; u2[j] = 0.f; }
    } else {
        unpack8(*(const u32x4*)(PC + (size_t)(row_base - 2) * PCW + 1024 + col), u2);
        unpack8(*(const u32x4*)(PC + (size_t)(row_base - 1) * PCW + 1024 + col), u1);
    }
#pragma unroll 4
    for (int r = 0; r < 16; ++r) {
        const size_t row = (size_t)(row_base + r);
        float uu[8], cb[8], o[8];
        unpack8(*(const u32x4*)(PC + row * PCW + 1024 + col), uu); unpack8(*(const u32x4*)(PC + row * PCW + col), cb);
#pragma unroll
        for (int j = 0; j < 8; ++j) { const float u = uu[j]; o[j] = cb[j] * (w0[j] * u2[j] + w1[j] * u1[j] + w2[j] * u); u2[j] = u1[j]; u1[j] = u; }
        *(u32x4*)(CV + row * DM + col) = pack8(o);
        if (t0 + r >= 8190) {
            float* op = out + O_CONVP + (size_t)(b * 2 + (t0 + r - 8190)) * 1024 + col;
            f32x4 x0, x1;
#pragma unroll
            for (int j = 0; j < 4; ++j) { x0[j] = u1[j]; x1[j] = u1[4 + j]; }
            *(f32x4*)op = x0; *(f32x4*)(op + 4) = x1;
        }
    }
}

__device__ __forceinline__ float norm1_row(const float* xrow, const bf16_t* mrow, float ss, const float* gpost, bf16_t* x1row, int lane) {
    const float rs1 = rsqrtf(ss * (1.f / DM) + EPS);
    f32x4 v[4]; float s = 0.f;
#pragma unroll
    for (int j = 0; j < 4; ++j) {
        const f32x4 xv = ((const f32x4*)xrow)[lane + 64 * j], gp = ((const f32x4*)gpost)[lane + 64 * j];
        const u32x2 mw = ((const u32x2*)mrow)[lane + 64 * j];
        v[j].x = xv.x + bf_lo(mw.x) * rs1 * gp.x; v[j].y = xv.y + bf_hi(mw.x) * rs1 * gp.y; v[j].z = xv.z + bf_lo(mw.y) * rs1 * gp.z; v[j].w = xv.w + bf_hi(mw.y) * rs1 * gp.w;
        s += (v[j].x * v[j].x + v[j].y * v[j].y) + (v[j].z * v[j].z + v[j].w * v[j].w);
    }
    const float rs2 = rsqrtf(wave_sum(s) * (1.f / DM) + EPS);
#pragma unroll
    for (int j = 0; j < 4; ++j) { u32x2 xo; xo.x = pk_bf16(v[j].x, v[j].y); xo.y = pk_bf16(v[j].z, v[j].w); ((u32x2*)x1row)[lane + 64 * j] = xo; }
    return rs2;
}
__device__ __forceinline__ void norm2_row(float* yrow, const bf16_t* x1row, const bf16_t* frow, float ss, const float* gpost, int lane) {
    const float rs = rsqrtf(ss * (1.f / DM) + EPS);
#pragma unroll
    for (int j = 0; j < 4; ++j) {
        const u32x2 xw = ((const u32x2*)x1row)[lane + 64 * j]; const f32x4 gp = ((const f32x4*)gpost)[lane + 64 * j];
        const u32x2 mw = ((const u32x2*)frow)[lane + 64 * j];
        f32x4 xv;
        xv.x = bf_lo(xw.x) + bf_lo(mw.x) * rs * gp.x; xv.y = bf_hi(xw.x) + bf_hi(mw.x) * rs * gp.y; xv.z = bf_lo(xw.y) + bf_lo(mw.y) * rs * gp.z; xv.w = bf_hi(xw.y) + bf_hi(mw.y) * rs * gp.w;
        ((f32x4*)yrow)[lane + 64 * j] = xv;
    }
}

#define WIN ((bf16_t*)(ws + WS_WIN))
#define WAO ((bf16_t*)(ws + WS_WAO))
#define WCO ((bf16_t*)(ws + WS_WCO))
#define WO ((bf16_t*)(ws + WS_WO))
#define WF1 ((bf16_t*)(ws + WS_WF1))
#define WF2 ((bf16_t*)(ws + WS_WF2))
#define H ((bf16_t*)(ws + WS_H))
#define Qb ((bf16_t*)(ws + WS_Q))
#define Kb ((bf16_t*)(ws + WS_K))
#define Vb ((bf16_t*)(ws + WS_V))
#define HID ((bf16_t*)(ws + WS_HID))
#define PC ((bf16_t*)(ws + WS_PC))
#define OG ((bf16_t*)(ws + WS_OG))
#define LSE ((float*)(ws + WS_LSE))
#define ATTN ((bf16_t*)(ws + WS_ATTN))
#define CV ((bf16_t*)(ws + WS_CV))
#define T ((bf16_t*)(ws + WS_T))
#define X1 ((bf16_t*)(ws + WS_T))
#define MIXIN ((bf16_t*)(ws + WS_MIXIN))
#define MIX ((bf16_t*)(ws + WS_MIX))
#define H2 ((bf16_t*)(ws + WS_H2))
#define Fb ((bf16_t*)(ws + WS_F))
#define SS ((float*)(ws + WS_SS))
#ifndef REP_P1
#define REP_P1 1
#endif
#ifndef REP_SYNC
#define REP_SYNC 1
#endif
#ifndef REP_P0
#define REP_P0 1
#endif
#ifndef REP_P2
#define REP_P2 1
#endif
constexpr int CPY_N = 16;
constexpr size_t CPY_T0 = (size_t)32 * 128 * 256, CPY_T1 = CPY_T0 + (size_t)32 * 512 * 256, CPY_TOT = CPY_T1 + (size_t)32 * 2048 * 256;
struct CopyOrder : pg8::StaticOrder {
    const f32x4 *s0, *s1, *s2; f32x4 *d0, *d1, *d2;
    mutable int ui;
    __device__ __forceinline__ bool next(int i, pg8::Unit& u) const {
        if (!pg8::StaticOrder::next(i, u)) return false;
        u.pn += 18; if (u.pn >= INW / 256) u.pn -= INW / 256;
        return true;
    }
    __device__ __forceinline__ void done(const pg8::Unit&) const {
        const size_t base = ((size_t)ui * G + c) * (size_t)(CPY_N * NTHREADS) + threadIdx.x; ++ui;
        f32x4 v[CPY_N];
#pragma unroll
        for (int j = 0; j < CPY_N; ++j) {
            const size_t f = base + (size_t)j * NTHREADS;
            if (f < CPY_T0) { if ((f & (128 * 256 - 1)) < 127 * 256) v[j] = __builtin_nontemporal_load(s0 + f + 256); }
            else if (f < CPY_T1) { const size_t r = f - CPY_T0; if ((r & (512 * 256 - 1)) < 511 * 256) v[j] = __builtin_nontemporal_load(s1 + r + 256); }
            else if (f < CPY_TOT) { const size_t r = f - CPY_T1; if ((r & (2048 * 256 - 1)) < 2047 * 256) v[j] = __builtin_nontemporal_load(s2 + r + 256); }
        }
#pragma unroll
        for (int j = 0; j < CPY_N; ++j) {
            const size_t f = base + (size_t)j * NTHREADS;
            if (f < CPY_T0) { if ((f & (128 * 256 - 1)) < 127 * 256) __builtin_nontemporal_store(v[j], d0 + f); }
            else if (f < CPY_T1) { const size_t r = f - CPY_T0; if ((r & (512 * 256 - 1)) < 511 * 256) __builtin_nontemporal_store(v[j], d1 + r); }
            else if (f < CPY_TOT) { const size_t r = f - CPY_T1; if ((r & (2048 * 256 - 1)) < 2047 * 256) __builtin_nontemporal_store(v[j], d2 + r); }
        }
        asm volatile("s_waitcnt vmcnt(0)" ::: "memory");
    }
};
constexpr size_t CPY_HOOK = (size_t)CPY_N * NTHREADS * ((NP / 256) * (INW / 256));
static_assert(CPY_HOOK >= CPY_T1 && CPY_HOOK <= CPY_TOT, "the tail lies in the third cache");

#define XB_TMO      128
#define XB_XCNT(j)  (256  + 64 * (j))
#define XB_XSUB(j)  (1280 + 64 * (j))
#define XB_XGEN(j)  (2304 + 64 * (j))
#define XB_TOP      3328
#define XB_TOPGEN   3392
#define XCD_BAR_WORDS 3456
#define XB_SPIN_CAP (1u << 18)

__device__ __forceinline__ unsigned xb_ld(unsigned* p)              { return __hip_atomic_load(p, __ATOMIC_RELAXED, __HIP_MEMORY_SCOPE_AGENT); }
__device__ __forceinline__ unsigned xb_add(unsigned* p, unsigned v) { return __hip_atomic_fetch_add(p, v, __ATOMIC_RELAXED, __HIP_MEMORY_SCOPE_AGENT); }
__device__ __forceinline__ unsigned xb_xcc_id() { return (unsigned)__builtin_amdgcn_s_getreg((3 << 11) | 20) & 0xFu; }
#define XB_SPIN(cond, bar) do { unsigned _sp = 0; while (cond) { __builtin_amdgcn_s_sleep(1); \
    if ((++_sp & 255u) == 0u) { if (xb_ld(&(bar)[XB_TMO])) break; if (_sp > XB_SPIN_CAP) { atomicAdd(&(bar)[XB_TMO], 1u); break; } } } } while (0)

struct XcdBarrier {
    unsigned* bar; unsigned x;
    volatile LAS unsigned* st;
};

__device__ __forceinline__ XcdBarrier xcd_barrier_post(unsigned* bar, volatile LAS unsigned* st) {
    XcdBarrier b; b.bar = bar; b.x = xb_xcc_id(); b.st = st;
    if (threadIdx.x == 0) (void)xb_add(&bar[XB_XCNT(b.x)], 1u);
    return b;
}
__device__ __forceinline__ void xcd_barrier_complete(unsigned* bar, unsigned x, unsigned& nloc, unsigned& nx) {
    const unsigned G = gridDim.x * gridDim.y * gridDim.z;
    unsigned sum, cnt, mine, sp = 0u;
    for (;;) {
        sum = 0u; cnt = 0u; mine = 0u;
#pragma unroll
        for (unsigned j = 0; j < 16; ++j) { const unsigned c = xb_ld(&bar[XB_XCNT(j)]); sum += c; cnt += (c > 0u) ? 1u : 0u; mine = (j == x) ? c : mine; }
        if (sum == G) break;
        __builtin_amdgcn_s_sleep(1);
        if ((++sp & 255u) == 0u) { if (xb_ld(&bar[XB_TMO])) break; if (sp > XB_SPIN_CAP) { atomicAdd(&bar[XB_TMO], 1u); break; } }
    }
    nloc = mine > 0u ? mine : 1u; nx = cnt > 0u ? cnt : 1u;
}

__device__ __forceinline__ void xcd_barrier(const XcdBarrier& b) {
    asm volatile("s_waitcnt vmcnt(0)" ::: "memory");
    __syncthreads();
    if (threadIdx.x == 0) {
        unsigned* bar = b.bar;
        __builtin_amdgcn_s_waitcnt(0);
        unsigned nloc = b.st[0], nx = b.st[1];
        if (nloc == 0u) { xcd_barrier_complete(bar, b.x, nloc, nx); b.st[0] = nloc; b.st[1] = nx; }
        const unsigned old = xb_add(&bar[XB_XSUB(b.x)], 1u);
        const unsigned gen = old / nloc;
        if (old + 1u == (gen + 1u) * nloc) {
            __builtin_amdgcn_fence(__ATOMIC_RELEASE, "agent");
            asm volatile("s_waitcnt vmcnt(0)" ::: "memory");
            const unsigned og = xb_add(&bar[XB_TOP], 1u);
            const unsigned tg = og / nx;
            if (og + 1u == (tg + 1u) * nx) xb_add(&bar[XB_TOPGEN], 1u);
            else XB_SPIN(xb_ld(&bar[XB_TOPGEN]) == tg, bar);
            __builtin_amdgcn_fence(__ATOMIC_ACQUIRE, "agent");
            xb_add(&bar[XB_XGEN(b.x)], 1u);
            asm volatile("s_waitcnt vmcnt(0)" ::: "memory");
        } else {
            XB_SPIN(xb_ld(&bar[XB_XGEN(b.x)]) == gen, bar);
            __builtin_amdgcn_fence(__ATOMIC_ACQUIRE, "agent");
            asm volatile("s_waitcnt vmcnt(0)" ::: "memory");
        }
    }
    __syncthreads();
}

struct Args { const float* in[17]; float* out; unsigned char* ws; };

__global__ void __launch_bounds__(NTHREADS, 2) fwd_kernel(Args a) {
    extern __shared__ __attribute__((aligned(16))) unsigned char lds_raw[];
    cg::grid_group grid = cg::this_grid();
    LAS unsigned char* lds = (LAS unsigned char*)lds_raw;
    const int tid = threadIdx.x, lane = tid & 63, wave = __builtin_amdgcn_readfirstlane(tid >> 6);
    const int G = gridDim.x, gw = blockIdx.x * 8 + wave, NGW = G * 8;
    const size_t gthreads = (size_t)G * NTHREADS;
    unsigned char* ws = a.ws; float* out = a.out;
    volatile LAS unsigned* bst = (volatile LAS unsigned*)(lds + 131072);
    if (tid == 0) { bst[0] = 0u; bst[1] = 0u; }
    __syncthreads();
    XcdBarrier xbar = xcd_barrier_post((unsigned*)(ws + WS_BAR), bst);
    if (a.ws == nullptr) grid.sync();
    {
        LAS float* scr = (LAS float*)(lds + wave * 8448);
        constexpr int I_IN = (DM / 64) * (INW / 32);
        for (int it = gw; it < I_IN; it += NGW) transpose_item<true>(a.in[6], DM, INW, WIN, scr, it, lane);
        for (int m = gw; m < NP + NS; m += NGW) {
            const float* xr = m < NP ? a.in[0] + (size_t)m * DM : a.in[1] + (size_t)(m - NP) * DM;
            rms_row_bf16(xr, a.in[13], H + (size_t)m * DM, lane);
        }
        for (size_t i = gtid_now(); i < (size_t)2 * MPAD; i += gthreads) SS[i] = 0.f;
    }
    xcd_barrier(xbar);

    {
        const int sb = ((int)blockIdx.x + G - (G >> 1)) % G;
        for (int tile = sb; tile < INW / 32; tile += (G >> 1)) {
            if (sb >= (G >> 1)) break;
            float r0, r1; skinny_tile<DM>(H + (size_t)NP * DM, DM, WIN, tile * 32, (LAS float*)lds, wave, lane, r0, r1);
            int tl = threadIdx.x; asm volatile("" : "+v"(tl)); const int b = tl >> 4, col = tile * 32 + 2 * (tl & 15);
            if (col < 4608) {
                const int which = col / 1536, cin = col - which * 1536, g = cin >> 9, h = (cin >> 6) & 7, d = cin & 63;
                *(unsigned*)(Qb + (size_t)which * (QKV_SZ / 2) + ((size_t)(g * 8 + h) * RQ + NP + b) * 64 + d) = pk_bf16(r0, r1);
                if (which) {
                    const int L = 128 << (2 * g); const size_t ob = g == 0 ? O_KV128S : (g == 1 ? O_KV512S : O_KV2048S);
                    float* o = out + ob + (((size_t)b * L + (L - 1)) * 2 + (which - 1)) * 512 + h * 64 + d;
                    o[0] = r0; o[1] = r1;
                }
            } else {
                *(unsigned*)(PC + (size_t)(NP + b) * PCW + (col - 4608)) = pk_bf16(r0, r1);
            }
        }
        pg8::Gemm g{H, WIN, NP, INW, DM}; CopyOrder S; S.init(NP, INW, G, (int)blockIdx.x);
        S.s0 = (const f32x4*)a.in[2]; S.s1 = (const f32x4*)a.in[3]; S.s2 = (const f32x4*)a.in[4];
        S.d0 = (f32x4*)(out + O_KV128S); S.d1 = (f32x4*)(out + O_KV512S); S.d2 = (f32x4*)(out + O_KV2048S); S.ui = 0;
        EpiIn E{Qb, PC};
        pg8::gemm_phase<EpiIn, CopyOrder, true, true>(lds, g, S, E);
        if ((int)blockIdx.x >= (G >> 1)) {
            const int tid = threadIdx.x, lane = tid & 63, wave = __builtin_amdgcn_readfirstlane(tid >> 6);
            LAS float* scr = (LAS float*)(lds + wave * 8448);
            constexpr int I_AO = (512 / 64) * (DM / 32), I_CO = (DM / 64) * (DM / 32), I_O = I_CO, I_F1 = (DM / 64) * (DFF / 32), I_F2 = (DFF / 64) * (DM / 32);
            constexpr int NIT = I_AO + I_CO + I_O + I_F1 + I_F2;
            const int hw = ((int)blockIdx.x - (G >> 1)) * 8 + wave, HW = (G - (G >> 1)) * 8;
            for (int it = hw; it < NIT; it += HW) {
                int r = it;
                if (r < I_AO) { transpose_item(a.in[8], 512, DM, WAO, scr, r, lane); continue; } r -= I_AO;
                if (r < I_CO) { transpose_item(a.in[9], DM, DM, WCO, scr, r, lane); continue; } r -= I_CO;
                if (r < I_O) { transpose_item(a.in[10], DM, DM, WO, scr, r, lane); continue; } r -= I_O;
                if (r < I_F1) { transpose_item<false, true>(a.in[11], DM, DFF, WF1, scr, r, lane, a.in[15]); continue; } r -= I_F1;
                transpose_item(a.in[12], DFF, DM, WF2, scr, r, lane);
            }
            const size_t ht = (size_t)((int)blockIdx.x - (G >> 1)) * NTHREADS + tid, HT = (size_t)(G - (G >> 1)) * NTHREADS;
            const f32x4* s2 = (const f32x4*)a.in[4]; f32x4* d2 = (f32x4*)(out + O_KV2048S);
#pragma unroll 4
            for (size_t f = CPY_HOOK + ht; f < CPY_TOT; f += HT) {
                const size_t r = f - CPY_T1;
                if ((r & (2048 * 256 - 1)) < 2047 * 256) { const f32x4 v = __builtin_nontemporal_load(s2 + r + 256); __builtin_nontemporal_store(v, d2 + r); }
            }
        }
    }
    xcd_barrier(xbar);

    {
        LAS unsigned char* wl = lds + wave * 8704;
        for (int t = gw; t < 3 * 8 * 512; t += NGW) attn_prompt_task(t, Qb, Kb, Vb, OG, LSE, wl, lane);
#if REP_P2 == 2
        for (int t = gw; t < 3 * 8 * 512; t += NGW) attn_prompt_task(t, Qb, Kb, Vb, OG, LSE, wl, lane);
#endif
        for (int t = NGW - 1 - gw; t < 768; t += NGW) attn_sample_task(t, Qb, Kb, Vb, a.in[2], a.in[3], a.in[4], (float*)(ws + WS_SO), (float*)(ws + WS_SO) + 768 * 64, (LAS float*)wl, lane);
        for (int t = gw; t < 2048; t += NGW) conv_prompt_task(t, PC, a.in[7], CV, out, lane);
        for (size_t i = gtid_now(); i < 32 * 128; i += gthreads) {
            const int b = (int)(i >> 7), col = (int)(i & 127) * 8; const size_t row = (size_t)(NP + b);
            float cc[8], ch[8], cb[8], o[8];
            const int pcol = 1024 + (col >> 7) * 256 + (col & 127);
            unpack8(*(const u32x4*)(PC + row * PCW + pcol), cc); unpack8(*(const u32x4*)(PC + row * PCW + pcol + 128), ch); unpack8(*(const u32x4*)(PC + row * PCW + col), cb);
            const float* st = a.in[5] + (size_t)b * 2048 + col; const float* cw = a.in[7] + col;
            float* oc = out + O_CONVS + (size_t)b * 2048 + col;
#pragma unroll
            for (int j = 0; j < 8; ++j) {
                const float u = cc[j] * ch[j], s0 = st[j], s1 = st[1024 + j];
                o[j] = cb[j] * (cw[j] * s0 + cw[1024 + j] * s1 + cw[2048 + j] * u);
                oc[j] = s1; oc[1024 + j] = u;
            }
            *(u32x4*)(CV + row * DM + col) = pack8(o);
        }
#pragma unroll
        for (int g = 0; g < 3; ++g) {
            const int sh = 2 * g, W = 128 << sh; float* dst = out + (g == 0 ? O_KV128P : (g == 1 ? O_KV512P : O_KV2048P));
            for (size_t i = gtid_now(); i < (size_t)256 * W; i += gthreads) {
                const int d8 = (int)(i & 7), h = (int)(i >> 3) & 7, kv = (int)(i >> 6) & 1; const int br = (int)(i >> 7), r = br & (W - 1), b = br >> (7 + sh);
                const int t = 8192 - W + r, rowp = (b << 13) | ((t & ((1 << sh) - 1)) << (13 - sh)) | (t >> sh);
                float f[8]; unpack8(*(const u32x4*)((kv ? Vb : Kb) + ((size_t)(g * 8 + h) * RQ + rowp) * 64 + d8 * 8), f);
                float* o = dst + i * 8;
                *(f32x4*)o = (f32x4){f[0], f[1], f[2], f[3]}; *(f32x4*)(o + 4) = (f32x4){f[4], f[5], f[6], f[7]};
            }
        }
    }
    xcd_barrier(xbar);

    for (size_t i = gtid_now(); i < (size_t)NP * 64; i += gthreads) {
        const size_t row = i >> 6; const int hd = (int)(i & 63), h = hd >> 3;
        const float L0 = LSE[row * 8 + h], L1 = LSE[((size_t)NP + row) * 8 + h], L2 = LSE[((size_t)2 * NP + row) * 8 + h];
        const float M = fmaxf(fmaxf(L0, L1), L2);
        float w0 = exp2f(L0 - M), w1 = exp2f(L1 - M), w2 = exp2f(L2 - M); const float inv = 1.f / (w0 + w1 + w2); w0 *= inv; w1 *= inv; w2 *= inv;
        float x0[8], x1[8], x2[8], o[8];
        unpack8(*(const u32x4*)(OG + row * 512 + hd * 8), x0); unpack8(*(const u32x4*)(OG + ((size_t)NP + row) * 512 + hd * 8), x1); unpack8(*(const u32x4*)(OG + ((size_t)2 * NP + row) * 512 + hd * 8), x2);
#pragma unroll
        for (int j = 0; j < 8; ++j) o[j] = w0 * x0[j] + w1 * x1[j] + w2 * x2[j];
        *(u32x4*)(ATTN + row * 512 + hd * 8) = pack8(o);
    }
    {
        const float* SO = (const float*)(ws + WS_SO); const float* SL = SO + 768 * 64;
        for (size_t i = gtid_now(); i < (size_t)NS * 8 * 64; i += gthreads) {
            const int bh = (int)(i >> 6), d = (int)(i & 63);
            const float L0 = SL[bh], L1 = SL[256 + bh], L2 = SL[512 + bh];
            const float M = fmaxf(fmaxf(L0, L1), L2);
            const float w0 = exp2f(L0 - M), w1 = exp2f(L1 - M), w2 = exp2f(L2 - M);
            const float o = (w0 * SO[(size_t)bh * 64 + d] + w1 * SO[(size_t)(256 + bh) * 64 + d] + w2 * SO[(size_t)(512 + bh) * 64 + d]) / (w0 + w1 + w2);
            ATTN[(size_t)(NP + (bh >> 3)) * 512 + (bh & 7) * 64 + d] = (bf16_t)(pk_bf16(o, 0.f) & 0xffffu);
        }
    }
    xcd_barrier(xbar);

    {
        if ((int)blockIdx.x < DM / 32) {
            const int n0 = (int)blockIdx.x * 32; float a0, a1, c0, c1;
            skinny_tile<512>(ATTN + (size_t)NP * 512, 512, WAO, n0, (LAS float*)lds, wave, lane, a0, a1);
            skinny_tile<DM>(CV + (size_t)NP * DM, DM, WCO, n0, (LAS float*)lds, wave, lane, c0, c1);
            int tl = threadIdx.x; asm volatile("" : "+v"(tl)); const int b = tl >> 4, col = n0 + 2 * (tl & 15);
            const unsigned ga = *(const unsigned*)(PC + (size_t)(NP + b) * PCW + 3072 + col), gc = *(const unsigned*)(PC + (size_t)(NP + b) * PCW + 4096 + col);
            *(unsigned*)(MIXIN + (size_t)(NP + b) * DM + col) = pk_bf16(sigm(bf_lo(ga)) * a0 + sigm(bf_lo(gc)) * c0, sigm(bf_hi(ga)) * a1 + sigm(bf_hi(gc)) * c1);
        }
        pg8::StaticOrder S; S.init(NP, DM, G, (int)blockIdx.x);
        { pg8::Gemm g{ATTN, WAO, NP, DM, 512}; EpiGateA E{PC, T}; pg8::gemm_phase<EpiGateA, pg8::StaticOrder, true, true>(lds, g, S, E); }
        { pg8::Gemm g{CV, WCO, NP, DM, DM}; EpiGateC E{PC, T, MIXIN}; pg8::gemm_phase<EpiGateC, pg8::StaticOrder, true, true>(lds, g, S, E); }
    }
    xcd_barrier(xbar);

    {
        if ((int)blockIdx.x < DM / 32) {
            const int n0 = (int)blockIdx.x * 32; float r0, r1;
            skinny_tile<DM>(MIXIN + (size_t)NP * DM, DM, WO, n0, (LAS float*)lds, wave, lane, r0, r1);
            int tl = threadIdx.x; asm volatile("" : "+v"(tl)); const int b = tl >> 4, col = n0 + 2 * (tl & 15);
            *(unsigned*)(MIX + (size_t)(NP + b) * DM + col) = pk_bf16(r0, r1);
            float sq = r0 * r0 + r1 * r1; sq += __shfl_xor(sq, 1); sq += __shfl_xor(sq, 2); sq += __shfl_xor(sq, 4); sq += __shfl_xor(sq, 8);
            if ((tl & 15) == 0) atomicAdd(SS + NP + b, sq);
        }
        pg8::Gemm g{MIXIN, WO, NP, DM, DM}; pg8::StaticOrder S; S.init(NP, DM, G, (int)blockIdx.x);
        EpiSS E{MIX, SS};
        pg8::gemm_phase<EpiSS, pg8::StaticOrder, true, true>(lds, g, S, E);
    }
    xcd_barrier(xbar);

    for (int m = gw; m < NP + NS; m += NGW) {
        const float* xr = m < NP ? a.in[0] + (size_t)m * DM : a.in[1] + (size_t)(m - NP) * DM;
        const float r2 = norm1_row(xr, MIX + (size_t)m * DM, SS[m], a.in[14], X1 + (size_t)m * DM, lane);
        if (lane == 0) SS[m] = r2;
    }
    xcd_barrier(xbar);

    {
        if ((int)blockIdx.x < DFF / 32) {
            const int n0 = (int)blockIdx.x * 32; float r0, r1;
            skinny_tile<DM>(X1 + (size_t)NP * DM, DM, WF1, n0, (LAS float*)lds, wave, lane, r0, r1);
            int tl = threadIdx.x; asm volatile("" : "+v"(tl)); const int b = tl >> 4, col = n0 + 2 * (tl & 15);
            const float sc = SS[NP + b], sc2 = sc * sc;
            r0 = fmaxf(r0, 0.f); r1 = fmaxf(r1, 0.f);
            *(unsigned*)(HID + (size_t)(NP + b) * DFF + col) = pk_bf16(r0 * r0 * sc2, r1 * r1 * sc2);
        }
        pg8::Gemm g{X1, WF1, NP, DFF, DM}; pg8::StaticOrder S; S.init(NP, DFF, G, (int)blockIdx.x);
        EpiRelu2 E{HID, SS};
        pg8::gemm_phase<EpiRelu2, pg8::StaticOrder, true, true>(lds, g, S, E);
    }
    xcd_barrier(xbar);

    {
        if ((int)blockIdx.x < DM / 32) {
            const int n0 = (int)blockIdx.x * 32; float r0, r1;
            skinny_tile<DFF>(HID + (size_t)NP * DFF, DFF, WF2, n0, (LAS float*)lds, wave, lane, r0, r1);
            int tl = threadIdx.x; asm volatile("" : "+v"(tl)); const int b = tl >> 4, col = n0 + 2 * (tl & 15);
            *(unsigned*)(Fb + (size_t)(NP + b) * DM + col) = pk_bf16(r0, r1);
            float sq = r0 * r0 + r1 * r1; sq += __shfl_xor(sq, 1); sq += __shfl_xor(sq, 2); sq += __shfl_xor(sq, 4); sq += __shfl_xor(sq, 8);
            if ((tl & 15) == 0) atomicAdd(SS + MPAD + NP + b, sq);
        }
        pg8::Gemm g{HID, WF2, NP, DM, DFF}; pg8::StaticOrder S; S.init(NP, DM, G, (int)blockIdx.x);
        EpiSS E{Fb, SS + MPAD};
        pg8::gemm_phase<EpiSS, pg8::StaticOrder, true, true>(lds, g, S, E);
    }
    xcd_barrier(xbar);

    for (int m = gw; m < NP + NS; m += NGW) {
        float* yr = m < NP ? out + O_YP + (size_t)m * DM : out + O_YS + (size_t)(m - NP) * DM;
        norm2_row(yr, X1 + (size_t)m * DM, Fb + (size_t)m * DM, SS[MPAD + m], a.in[16], lane);
    }
}

extern "C" void kernel_launch(void* const* d_in, const int* in_sizes, int n_in, void* d_out, int out_size, void* d_ws, size_t ws_size, hipStream_t stream) {
    static int grid_blocks = 0;
    if (grid_blocks == 0) {
        if (n_in != 17 || ws_size < WS_END) { fprintf(stderr, "kernel_launch: unexpected n_in %d or ws_size %zu (< %zu)\n", n_in, ws_size, (size_t)WS_END); grid_blocks = -1; return; }
        int dev = 0, cus = 0, per_cu = 0;
        hipGetDevice(&dev);
        hipDeviceGetAttribute(&cus, hipDeviceAttributeMultiprocessorCount, dev);
        if (hipFuncSetAttribute((const void*)fwd_kernel, hipFuncAttributeMaxDynamicSharedMemorySize, LDS_BYTES) != hipSuccess) { fprintf(stderr, "kernel_launch: hipFuncSetAttribute failed\n"); grid_blocks = -1; return; }
        if (hipOccupancyMaxActiveBlocksPerMultiprocessor(&per_cu, (const void*)fwd_kernel, NTHREADS, LDS_BYTES) != hipSuccess || per_cu < 1) { fprintf(stderr, "kernel_launch: occupancy query failed (%d)\n", per_cu); per_cu = 1; (void)hipGetLastError(); }
        if (per_cu > 1) per_cu = 1;
        grid_blocks = cus * per_cu;
    }
    if (grid_blocks < 0) return;
    if (hipMemsetAsync((char*)d_ws + WS_BAR, 0, 16384, stream) != hipSuccess) { fprintf(stderr, "kernel_launch: memset failed\n"); return; }
    Args a{};
    for (int i = 0; i < 17; ++i) a.in[i] = (const float*)d_in[i];
    a.out = (float*)d_out; a.ws = (unsigned char*)d_ws;
    void* args[] = {&a};
    hipError_t e = hipLaunchCooperativeKernel((const void*)fwd_kernel, dim3(grid_blocks), dim3(NTHREADS), args, LDS_BYTES, stream);
    if (e != hipSuccess) fprintf(stderr, "cooperative launch failed: %s (grid %d)\n", hipGetErrorString(e), grid_blocks);
}
```
